# Optimizing an MI355X kernel written in HIP

```python
import math
import jax, jax.numpy as jnp
from jax import lax
import numpy as np

D_MODEL = 2048
BATCH = 16
SEQ = 2048
DEPTH = 4

HEAD_DIM = 128
A_HEADS = 4
A_QK_DIM = 64
A_V_DIM = 2 * A_QK_DIM
B_HEADS = 4
C_HEADS = 6
C_PATTERNS = ((128, 1), (512, 4), (2048, 16))
BLOCK = 128
D_FF = 4 * D_MODEL
N_BRANCH = 3
EPS = 1e-6
NEG_INF = -1e30

A_QK_W = A_HEADS * 2 * A_QK_DIM
A_WIDTH = A_HEADS * A_V_DIM
B_WIDTH = B_HEADS * HEAD_DIM
C_WIDTH = C_HEADS * HEAD_DIM
PROJ_SPLITS = (A_QK_W, A_QK_W, A_WIDTH,
               B_WIDTH, B_WIDTH, B_WIDTH, B_HEADS,
               C_WIDTH, C_WIDTH, C_WIDTH,
               N_BRANCH * D_MODEL)
IN_COLS = sum(PROJ_SPLITS)

kernel_name = "hybrid_diff_fox_dilated_gated_block"


def _rms(x, g):
    x32 = x.astype(jnp.float32)
    y = x32 * lax.rsqrt(jnp.mean(x32 * x32, axis=-1, keepdims=True) + EPS)
    return (y * g.astype(jnp.float32)).astype(x.dtype)


def _alibi_slopes(n):
    return 2.0 ** (-8.0 * jnp.arange(1, n + 1, dtype=jnp.float32) / n)


def _diff_attention(q, k, v, lam, slopes):
    S = q.shape[1]
    scale = A_QK_DIM ** -0.5
    q = q.astype(jnp.float32); k = k.astype(jnp.float32); v = v.astype(jnp.float32)
    outs = []
    for blk in range(S // BLOCK):
        q0 = blk * BLOCK
        nk = q0 + BLOCK
        dist = (q0 + jnp.arange(BLOCK))[:, None] - jnp.arange(nk)[None, :]
        bias = -slopes[:, None, None] * dist.astype(jnp.float32)
        s = jnp.einsum('bqhmd,bkhmd->bhmqk', q[:, q0:nk], k[:, :nk]) * scale + bias[None, :, None]
        s = jnp.where(dist >= 0, s, NEG_INF)
        p = jax.nn.softmax(s, axis=-1)
        p = p[:, :, 0] - lam * p[:, :, 1]
        outs.append(jnp.einsum('bhqk,bkhe->bqhe', p, v[:, :nk]))
    return jnp.concatenate(outs, axis=1)


def _forgetting_attention(q, k, v, logf_cum):
    S = q.shape[1]
    scale = HEAD_DIM ** -0.5
    q = q.astype(jnp.float32); k = k.astype(jnp.float32); v = v.astype(jnp.float32)
    c = jnp.transpose(logf_cum, (0, 2, 1))
    outs = []
    for blk in range(S // BLOCK):
        q0 = blk * BLOCK
        nk = q0 + BLOCK
        dist = (q0 + jnp.arange(BLOCK))[:, None] - jnp.arange(nk)[None, :]
        decay = c[:, :, q0:nk, None] - c[:, :, None, :nk]
        s = jnp.einsum('bqhd,bkhd->bhqk', q[:, q0:nk], k[:, :nk]) * scale + decay
        s = jnp.where(dist >= 0, s, NEG_INF)
        p = jax.nn.softmax(s, axis=-1)
        outs.append(jnp.einsum('bhqk,bkhd->bqhd', p, v[:, :nk]))
    return jnp.concatenate(outs, axis=1)


def _dilated_pattern(q, k, v, slopes, window, dilation):
    B, S, H, dh = q.shape
    L = S // dilation
    nw = window // dilation
    nb = -(-L // BLOCK)
    Lp = nb * BLOCK
    scale = dh ** -0.5

    def to_sub(t):
        t = t.astype(jnp.float32).reshape(B, L, dilation, H, dh).transpose(0, 2, 3, 1, 4)
        t = jnp.pad(t, ((0, 0), (0, 0), (0, 0), (0, Lp - L), (0, 0)))
        return t.reshape(B, dilation, H, nb, BLOCK, dh)

    def band(t):
        t = jnp.pad(t, ((0, 0), (0, 0), (0, 0), (1, 0), (0, 0), (0, 0)))
        return jnp.concatenate([t[:, :, :, :-1], t[:, :, :, 1:]], axis=4)

    qs = to_sub(q)
    kb = band(to_sub(k))
    vb = band(to_sub(v))
    i = jnp.arange(BLOCK)[:, None]
    j = jnp.arange(2 * BLOCK)[None, :]
    dist = BLOCK + i - j
    blk = jnp.arange(nb)[:, None, None]
    valid = (dist >= 0) & (dist <= nw) & ((blk > 0) | (j >= BLOCK))
    bias = -slopes[:, None, None, None] * (dist * dilation).astype(jnp.float32)
    s = jnp.einsum('brhnqd,brhnkd->brhnqk', qs, kb) * scale + bias[None, None]
    s = jnp.where(valid, s, NEG_INF)
    m = jnp.max(s, axis=-1)
    p = jnp.exp(s - m[..., None])
    l = jnp.sum(p, axis=-1)
    o = jnp.einsum('brhnqk,brhnkd->brhnqd', p, vb) / l[..., None]

    def from_sub(t):
        rest = t.shape[5:]
        t = t.reshape((B, dilation, H, Lp) + rest)[:, :, :, :L]
        t = jnp.moveaxis(t, 3, 1)
        return t.reshape((B, S, H) + rest)

    return from_sub(o), from_sub(m), from_sub(l)


def _dilated_mixture(q, k, v, slopes):
    parts = [_dilated_pattern(q, k, v, slopes, w, d) for (w, d) in C_PATTERNS]
    m_all = jnp.stack([p[1] for p in parts])
    m_top = jnp.max(m_all, axis=0)
    wts = jnp.stack([p[2] * jnp.exp(p[1] - m_top) for p in parts])
    o_all = jnp.stack([p[0] for p in parts])
    return jnp.sum(wts[..., None] * o_all, axis=0) / jnp.sum(wts, axis=0)[..., None]


def setup_inputs(seed: int = 0) -> dict:
    key = jax.random.key(seed)
    ks = jax.random.split(key, 24)

    def nrm(k, shape, scale):
        return jax.random.normal(k, shape, jnp.float32) * scale

    def gain(k, shape):
        return 1.0 + 0.02 * jax.random.normal(k, shape, jnp.float32)

    return {
        "x": nrm(ks[0], (BATCH, SEQ, D_MODEL), 1.0),
        "g_mix_norm": gain(ks[1], (DEPTH, D_MODEL)),
        "w_in": nrm(ks[2], (DEPTH, D_MODEL, IN_COLS), D_MODEL ** -0.5),
        "b_forget": 2.0 + 0.1 * jax.random.normal(ks[3], (DEPTH, B_HEADS), jnp.float32),
        "b_gate": nrm(ks[4], (DEPTH, N_BRANCH * D_MODEL), 0.02),
        "g_q_a": gain(ks[5], (DEPTH, A_QK_DIM)),
        "g_k_a": gain(ks[6], (DEPTH, A_QK_DIM)),
        "lam_q1": nrm(ks[7], (DEPTH, A_QK_DIM), 0.1),
        "lam_k1": nrm(ks[8], (DEPTH, A_QK_DIM), 0.1),
        "lam_q2": nrm(ks[9], (DEPTH, A_QK_DIM), 0.1),
        "lam_k2": nrm(ks[10], (DEPTH, A_QK_DIM), 0.1),
        "g_sub_a": gain(ks[11], (DEPTH, A_V_DIM)),
        "g_q_b": gain(ks[12], (DEPTH, HEAD_DIM)),
        "g_k_b": gain(ks[13], (DEPTH, HEAD_DIM)),
        "g_q_c": gain(ks[14], (DEPTH, HEAD_DIM)),
        "g_k_c": gain(ks[15], (DEPTH, HEAD_DIM)),
        "w_up_a": nrm(ks[16], (DEPTH, A_WIDTH, D_MODEL), A_WIDTH ** -0.5),
        "w_up_b": nrm(ks[17], (DEPTH, B_WIDTH, D_MODEL), B_WIDTH ** -0.5),
        "w_up_c": nrm(ks[18], (DEPTH, C_WIDTH, D_MODEL), C_WIDTH ** -0.5),
        "w_out": nrm(ks[19], (DEPTH, D_MODEL, D_MODEL), D_MODEL ** -0.5),
        "g_ffn_norm": gain(ks[20], (DEPTH, D_MODEL)),
        "w_ff_in": nrm(ks[21], (DEPTH, D_MODEL, D_FF), D_MODEL ** -0.5),
        "w_ff_out": nrm(ks[22], (DEPTH, D_FF, D_MODEL), D_FF ** -0.5),
    }


def reference(x, g_mix_norm, w_in, b_forget, b_gate, g_q_a, g_k_a, lam_q1, lam_k1, lam_q2, lam_k2,
              g_sub_a, g_q_b, g_k_b, g_q_c, g_k_c, w_up_a, w_up_b, w_up_c, w_out,
              g_ffn_norm, w_ff_in, w_ff_out):
    B, S, _ = x.shape
    dt = x.dtype
    split_idx = [int(v) for v in np.cumsum(PROJ_SPLITS)[:-1]]
    slopes_a = _alibi_slopes(A_HEADS)
    slopes_c = _alibi_slopes(C_HEADS)
    for layer in range(DEPTH):
        lam_init = 0.8 - 0.6 * math.exp(-0.3 * layer)
        h = _rms(x, g_mix_norm[layer])
        z = h @ w_in[layer]
        qa, ka, va, qb, kb, vb, fb, qc, kc, vc, gl = jnp.split(z, split_idx, axis=-1)

        qa = _rms(qa.reshape(B, S, A_HEADS, 2, A_QK_DIM), g_q_a[layer])
        ka = _rms(ka.reshape(B, S, A_HEADS, 2, A_QK_DIM), g_k_a[layer])
        va = va.reshape(B, S, A_HEADS, A_V_DIM)
        lam = (jnp.exp(jnp.sum(lam_q1[layer].astype(jnp.float32) * lam_k1[layer].astype(jnp.float32)))
               - jnp.exp(jnp.sum(lam_q2[layer].astype(jnp.float32) * lam_k2[layer].astype(jnp.float32)))
               + lam_init)
        oa = _diff_attention(qa, ka, va, lam, slopes_a)
        oa = (_rms(oa, g_sub_a[layer]) * (1.0 - lam_init)).reshape(B, S, A_WIDTH).astype(dt)

        qb = _rms(qb.reshape(B, S, B_HEADS, HEAD_DIM), g_q_b[layer])
        kb = _rms(kb.reshape(B, S, B_HEADS, HEAD_DIM), g_k_b[layer])
        vb = vb.reshape(B, S, B_HEADS, HEAD_DIM)
        logf = jax.nn.log_sigmoid(fb.astype(jnp.float32) + b_forget[layer].astype(jnp.float32))
        logf_cum = jnp.cumsum(logf, axis=1)
        ob = _forgetting_attention(qb, kb, vb, logf_cum).reshape(B, S, B_WIDTH).astype(dt)

        qc = _rms(qc.reshape(B, S, C_HEADS, HEAD_DIM), g_q_c[layer])
        kc = _rms(kc.reshape(B, S, C_HEADS, HEAD_DIM), g_k_c[layer])
        vc = vc.reshape(B, S, C_HEADS, HEAD_DIM)
        oc = _dilated_mixture(qc, kc, vc, slopes_c).reshape(B, S, C_WIDTH).astype(dt)

        gates = jax.nn.sigmoid(gl + b_gate[layer]).reshape(B, S, N_BRANCH, D_MODEL)
        merged = (gates[:, :, 0] * (oa @ w_up_a[layer])
                  + gates[:, :, 1] * (ob @ w_up_b[layer])
                  + gates[:, :, 2] * (oc @ w_up_c[layer]))
        x = x + merged @ w_out[layer]

        h2 = _rms(x, g_ffn_norm[layer])
        x = x + jnp.square(jax.nn.relu(h2 @ w_ff_in[layer])) @ w_ff_out[layer]
    return x
```

```cpp
#include <hip/hip_runtime.h>
#include <cstdio>
#include <cstdint>
namespace pg8 {
#define PG8_LAS __attribute__((address_space(3)))
typedef unsigned short bf16_t;
typedef short bf16x8 __attribute__((ext_vector_type(8)));
typedef float f32x4 __attribute__((ext_vector_type(4)));
typedef unsigned u32x4 __attribute__((ext_vector_type(4)));
constexpr int BM = 256, BK = 64, HALF = 128, HTB = HALF * BK * 2  , STAGE_BYTES = 8 * HTB, NXCD = 8, WGM = 8;

__host__ __device__ __forceinline__ int lds_byte(int r, int c) { const int st = (r >> 4) * 2 + (c >> 5), rr = r & 15, cc = c & 31, ob = rr * 64 + cc * 2; return st * 1024 + (ob ^ (((ob >> 9) & 1) << 5)); }
__host__ __device__ __forceinline__ void stage_rc(int b, int& R, int& C) { const int st = b / 1024, sb = b % 1024, swz = sb ^ (((sb >> 9) & 1) << 5); R = (st >> 1) * 16 + swz / 64; C = (st & 1) * 32 + (swz % 64) / 2; }
__host__ __device__ __forceinline__ int perm32(int rho) { const int n = rho >> 4, i = rho & 15; return 8 * (i >> 2) + 4 * n + (i & 3); }

struct Unit { int pm, pn; };
struct Gemm { const bf16_t* A; const bf16_t* Bt; int M, N, K, lda; };

struct StaticOrder {
    int nM, nN, nwg, G, c;
    __host__ __device__ void init(int M, int N, int G_, int c_) { nM = M / BM; nN = N / BM; nwg = nM * nN; G = G_; c = c_; }
    __host__ __device__ bool next(int i, Unit& u) const {
        const long L = (long)i * G + c; if (L >= nwg) return false;
        int wgid = (int)L; { const int q = nwg / NXCD, r = nwg % NXCD, xcd = wgid % NXCD, off = wgid / NXCD; wgid = (xcd < r ? xcd * (q + 1) : r * (q + 1) + (xcd - r) * q) + off; }
        const int nig = WGM * nN, gid = wgid / nig, fm = gid * WGM, gsz = (nM - fm) < WGM ? (nM - fm) : WGM;
        u.pm = fm + ((wgid % nig) % gsz); u.pn = (wgid % nig) / gsz; return true;
    }
    __device__ __forceinline__ void a_ready(const Unit&) const {}
    __device__ __forceinline__ void done(const Unit&) const {}
};

typedef __bf16 bf16x2_t __attribute__((ext_vector_type(2)));
typedef float f32x2_t __attribute__((ext_vector_type(2)));
__device__ __forceinline__ unsigned cvt_pk_bf16(float lo, float hi) { const f32x2_t v = {lo, hi}; return __builtin_bit_cast(unsigned, __builtin_convertvector(v, bf16x2_t)); }
#define PG8_GAS __attribute__((address_space(1)))
__device__ __forceinline__ u32x4 pack8(f32x4 v0, f32x4 v1) { u32x4 w; w.x = cvt_pk_bf16(v0[0], v0[1]); w.y = cvt_pk_bf16(v0[2], v0[3]); w.z = cvt_pk_bf16(v1[0], v1[1]); w.w = cvt_pk_bf16(v1[2], v1[3]); return w; }
__device__ __forceinline__ float sigm(float v) { return __builtin_amdgcn_rcpf(1.0f + __builtin_amdgcn_exp2f(-1.4426950408889634f * v)); }

constexpr int E_ZQ = 5376, E_GW = 6144, E_DM = 2048, E_DFF = 8192;

struct EpiZ {
    static constexpr bool PERM = true, AFTER_DRAIN = false;
    bf16_t* Z; bf16_t* Gt; const float* bgate;
    __device__ __forceinline__ void operator()(const f32x4 (&acc)[2][2][4][2], const Unit& u, int wr, int wc, int fr, int fq) const {
        const int row0 = u.pm * BM + wr * 64 + fr; const int colt = u.pn * BM;
        if (colt < E_ZQ) {
            const int col0 = colt + wc * 32 + 8 * fq;
#pragma unroll
            for (int ai = 0; ai < 2; ++ai)
#pragma unroll
                for (int m = 0; m < 4; ++m) { PG8_GAS bf16_t* rowp = (PG8_GAS bf16_t*)Z + (size_t)(row0 + ai * HALF + m * 16) * E_ZQ + col0;
#pragma unroll
                    for (int bj = 0; bj < 2; ++bj) *(PG8_GAS u32x4*)(rowp + bj * HALF) = pack8(acc[ai][bj][m][0], acc[ai][bj][m][1]); }
        } else {
            const int gc0 = colt - E_ZQ + wc * 32 + 8 * fq;
            f32x4 bv[2][2];
#pragma unroll
            for (int bj = 0; bj < 2; ++bj)
#pragma unroll
                for (int n = 0; n < 2; ++n) bv[bj][n] = *(const PG8_GAS f32x4*)((const PG8_GAS float*)bgate + gc0 + bj * HALF + 4 * n);
#pragma unroll
            for (int ai = 0; ai < 2; ++ai)
#pragma unroll
                for (int m = 0; m < 4; ++m) { PG8_GAS bf16_t* rowp = (PG8_GAS bf16_t*)Gt + (size_t)(row0 + ai * HALF + m * 16) * E_GW + gc0;
#pragma unroll
                    for (int bj = 0; bj < 2; ++bj) { f32x4 v0 = acc[ai][bj][m][0] + bv[bj][0], v1 = acc[ai][bj][m][1] + bv[bj][1];
#pragma unroll
                        for (int j = 0; j < 4; ++j) { v0[j] = sigm(v0[j]); v1[j] = sigm(v1[j]); }
                        *(PG8_GAS u32x4*)(rowp + bj * HALF) = pack8(v0, v1); } }
        }
    }
};
template <int MODE> struct EpiMerge {
    static constexpr bool PERM = true, AFTER_DRAIN = false;
    const bf16_t* Gt; int gofs; float* M32; bf16_t* Out;
    __device__ __forceinline__ void operator()(const f32x4 (&acc)[2][2][4][2], const Unit& u, int wr, int wc, int fr, int fq) const {
        const size_t urow = (size_t)(u.pm * BM + wr * 64); const int ucol = u.pn * BM + wc * 32;
        const PG8_GAS char* gB = (const PG8_GAS char*)Gt + (urow * E_GW + gofs + ucol) * 2; const unsigned gL = (unsigned)(fr * E_GW + 8 * fq) * 2u;
        PG8_GAS char* mB = (PG8_GAS char*)M32 + (urow * E_DM + ucol) * 4; const unsigned mL = (unsigned)(fr * E_DM + 8 * fq) * 4u;
        PG8_GAS char* oB = (PG8_GAS char*)Out + (urow * E_DM + ucol) * 2; const unsigned oL = (unsigned)(fr * E_DM + 8 * fq) * 2u;
#pragma unroll
        for (int ai = 0; ai < 2; ++ai)
#pragma unroll
            for (int m = 0; m < 4; ++m) { const size_t dr = (size_t)(ai * HALF + m * 16);
#pragma unroll
                for (int bj = 0; bj < 2; ++bj) {
                    u32x4 gw = (u32x4){0x3f803f80u, 0x3f803f80u, 0x3f803f80u, 0x3f803f80u};
                    if (MODE != 4) gw = *(const PG8_GAS u32x4*)(gB + dr * E_GW * 2 + bj * HALF * 2 + gL);
                    f32x4 g0, g1;
                    g0[0] = __uint_as_float(gw.x << 16); g0[1] = __uint_as_float(gw.x & 0xffff0000u); g0[2] = __uint_as_float(gw.y << 16); g0[3] = __uint_as_float(gw.y & 0xffff0000u);
                    g1[0] = __uint_as_float(gw.z << 16); g1[1] = __uint_as_float(gw.z & 0xffff0000u); g1[2] = __uint_as_float(gw.w << 16); g1[3] = __uint_as_float(gw.w & 0xffff0000u);
                    f32x4 v0 = acc[ai][bj][m][0] * g0, v1 = acc[ai][bj][m][1] * g1;
                    PG8_GAS char* mp = mB + dr * E_DM * 4 + bj * HALF * 4 + mL;
                    if (MODE == 1 || MODE == 2) { v0 += *(const PG8_GAS f32x4*)mp; v1 += *(const PG8_GAS f32x4*)(mp + 16); }
                    if (MODE <= 1) { *(PG8_GAS f32x4*)mp = v0; *(PG8_GAS f32x4*)(mp + 16) = v1; }
                    else *(PG8_GAS u32x4*)(oB + dr * E_DM * 2 + bj * HALF * 2 + oL) = pack8(v0, v1); }
                asm volatile("" ::: "memory"); }
    }
};
struct EpiResid {
    static constexpr bool PERM = false, AFTER_DRAIN = false;
    float* X; int ldc;
    __device__ __forceinline__ void operator()(const f32x4 (&acc)[2][2][4][2], const Unit& u, int wr, int wc, int fr, int fq) const {
        const int row0 = u.pm * BM + wr * 64 + fr, col0 = u.pn * BM + wc * 32 + 4 * fq;
#pragma unroll
        for (int ai = 0; ai < 2; ++ai)
#pragma unroll
            for (int m = 0; m < 4; ++m) { PG8_GAS float* rowp = (PG8_GAS float*)X + (size_t)(row0 + ai * HALF + m * 16) * ldc + col0;
#pragma unroll
                for (int bj = 0; bj < 2; ++bj)
#pragma unroll
                    for (int n = 0; n < 2; ++n) { PG8_GAS float* p = rowp + bj * HALF + n * 16; *(PG8_GAS f32x4*)p = *(const PG8_GAS f32x4*)p + acc[ai][bj][m][n]; }
                asm volatile("" ::: "memory"); }
    }
};
struct EpiRelu2 {
    static constexpr bool PERM = true, AFTER_DRAIN = false;
    bf16_t* U; int ldc;
    __device__ __forceinline__ void operator()(const f32x4 (&acc)[2][2][4][2], const Unit& u, int wr, int wc, int fr, int fq) const {
        const int row0 = u.pm * BM + wr * 64 + fr, col0 = u.pn * BM + wc * 32 + 8 * fq;
#pragma unroll
        for (int ai = 0; ai < 2; ++ai)
#pragma unroll
            for (int m = 0; m < 4; ++m) { PG8_GAS bf16_t* rowp = (PG8_GAS bf16_t*)U + (size_t)(row0 + ai * HALF + m * 16) * ldc + col0;
#pragma unroll
                for (int bj = 0; bj < 2; ++bj) { f32x4 v0 = acc[ai][bj][m][0], v1 = acc[ai][bj][m][1];
#pragma unroll
                    for (int j = 0; j < 4; ++j) { const float a = fmaxf(v0[j], 0.f), b = fmaxf(v1[j], 0.f); v0[j] = a * a; v1[j] = b * b; }
                    *(PG8_GAS u32x4*)(rowp + bj * HALF) = pack8(v0, v1); } }
    }
};

template <class Epi, class Sched, bool ALIGN_EPI = false, bool SP2 = false>
__device__ __forceinline__ void gemm_phase(PG8_LAS unsigned char* lds, const Gemm g, const Sched& S, const Epi& E, const int tid) {
    const int wid = __builtin_amdgcn_readfirstlane(tid >> 6), lane = tid & 63, wr = wid >> 2, wc = wid & 3, fr = lane & 15, fq = lane >> 4;
    const int K = g.K, nt = K / BK, lda = g.lda;
    unsigned voffA[2], voffB[2];
#pragma unroll
    for (int i = 0; i < 2; ++i) { int R, C; stage_rc(tid * 16 + i * 8192, R, C); const int Rb = Epi::PERM ? ((R & ~31) + perm32(R & 31)) : R;
        voffA[i] = (unsigned)(R * lda + C) * 2u; voffB[i] = (unsigned)(Rb * K + C) * 2u; }
    const size_t kstep = (size_t)(BK * 2);
    const size_t hstepA = (size_t)HALF * lda * 2, hstepB = (size_t)HALF * K * 2;
    const size_t tstepA = 2 * hstepA, tstepB = 2 * hstepB;
    const unsigned ldsw = (unsigned)wid * 1024u;
    const int aoff = lds_byte(wr * 64 + fr, fq * 8), boff = lds_byte(wc * 32 + fr, fq * 8);
#define PG8_SA(b, h) (((b) * 2 + (h)) * HTB)
#define PG8_SB(b, h) ((4 + (b) * 2 + (h)) * HTB)
#define PG8_STAGE(bufoff, gbase, voff) do { _Pragma("unroll") for (int _i = 0; _i < 2; ++_i) \
        __builtin_amdgcn_global_load_lds((const unsigned*)((const char*)(gbase) + (voff)[_i]), (PG8_LAS unsigned*)(lds + (bufoff) + ldsw + _i * 8192), 16, 0, 0); } while (0)
#define PG8_LDA(dst, b, h) do { _Pragma("unroll") for (int m = 0; m < 4; ++m) _Pragma("unroll") for (int k = 0; k < 2; ++k) dst[m][k] = *(const PG8_LAS bf16x8*)(lds + PG8_SA(b, h) + aoff + m * 2048 + k * 1024); } while (0)
#define PG8_LDB(dst, b, h) do { _Pragma("unroll") for (int n = 0; n < 2; ++n) _Pragma("unroll") for (int k = 0; k < 2; ++k) dst[n][k] = *(const PG8_LAS bf16x8*)(lds + PG8_SB(b, h) + boff + n * 2048 + k * 1024); } while (0)
#define PG8_MMA(ai, bj, At, Bt) do { __builtin_amdgcn_s_setprio(1); _Pragma("unroll") for (int m = 0; m < 4; ++m) _Pragma("unroll") for (int n = 0; n < 2; ++n) _Pragma("unroll") for (int k = 0; k < 2; ++k) \
        acc[ai][bj][m][n] = __builtin_amdgcn_mfma_f32_16x16x32_bf16(Bt[n][k], At[m][k], acc[ai][bj][m][n], 0, 0, 0); __builtin_amdgcn_s_setprio(0); } while (0)
#define PG8_WAIT_V(n) asm volatile("s_waitcnt vmcnt(" #n ")" ::: "memory")
#define PG8_WAIT_L(n) asm volatile("s_waitcnt lgkmcnt(" #n ")" ::: "memory")
#define PG8_BAR __builtin_amdgcn_s_barrier()
#define PG8_SCHED __builtin_amdgcn_sched_barrier(0)
    Unit cur, nxt; int ui = 0;
    if (!S.next(0, cur)) return;
    f32x4 acc[2][2][4][2];
#pragma unroll
    for (int a = 0; a < 2; ++a)
#pragma unroll
        for (int b = 0; b < 2; ++b)
#pragma unroll
            for (int m = 0; m < 4; ++m)
#pragma unroll
                for (int n = 0; n < 2; ++n) acc[a][b][m][n] = (f32x4){0.f, 0.f, 0.f, 0.f};
    bf16x8 At[4][2], B0[2][2], B1[2][2];
    const char* cA = (const char*)g.A + (size_t)cur.pm * tstepA; const char* cB = (const char*)g.Bt + (size_t)cur.pn * tstepB;
    S.a_ready(cur);
    if constexpr (SP2) {
        PG8_STAGE(PG8_SB(0, 0), cB, voffB); PG8_STAGE(PG8_SB(0, 1), cB + hstepB, voffB); PG8_STAGE(PG8_SA(0, 0), cA, voffA); PG8_STAGE(PG8_SA(0, 1), cA + hstepA, voffA);
        if (wr == 1) PG8_BAR;
        PG8_WAIT_V(2); PG8_BAR;
        PG8_STAGE(PG8_SB(1, 0), cB + kstep, voffB); PG8_STAGE(PG8_SA(1, 0), cA + kstep, voffA); PG8_STAGE(PG8_SB(1, 1), cB + hstepB + kstep, voffB);
        PG8_WAIT_V(6); PG8_BAR;
    } else {
        PG8_STAGE(PG8_SB(0, 0), cB, voffB); PG8_STAGE(PG8_SA(0, 0), cA, voffA); PG8_STAGE(PG8_SB(0, 1), cB + hstepB, voffB); PG8_STAGE(PG8_SA(0, 1), cA + hstepA, voffA);
        if (wr == 1) PG8_BAR;
        PG8_WAIT_V(4); PG8_BAR;
        PG8_STAGE(PG8_SB(1, 0), cB + kstep, voffB); PG8_STAGE(PG8_SA(1, 0), cA + kstep, voffA); PG8_STAGE(PG8_SB(1, 1), cB + hstepB + kstep, voffB);
        PG8_WAIT_V(6); PG8_BAR;
    }
    for (;;) {
        const bool has_next = S.next(ui + 1, nxt);
        const char* nA = has_next ? (const char*)g.A + (size_t)nxt.pm * tstepA : cA; const char* nB = has_next ? (const char*)g.Bt + (size_t)nxt.pn * tstepB : cB;
        for (int t = 0; t < nt; t += 2) {
            const bool last = (t == nt - 2);
            const char* a1 = cA + (size_t)(t + 1) * kstep;
            const char* a2 = last ? nA : cA + (size_t)(t + 2) * kstep; const char* b2 = last ? nB : cB + (size_t)(t + 2) * kstep;
            const char* a3 = a2 + kstep; const char* b3 = b2 + kstep;
            if (last && has_next) S.a_ready(nxt);
            if constexpr (SP2) {
            PG8_LDB(B0, 0, 0); PG8_LDB(B1, 0, 1); PG8_SCHED; PG8_LDA(At, 0, 0); PG8_STAGE(PG8_SA(1, 1), a1 + hstepA, voffA);
            PG8_WAIT_V(8); PG8_WAIT_L(0); PG8_BAR; PG8_MMA(0, 0, At, B0); PG8_MMA(0, 1, At, B1); PG8_BAR; PG8_SCHED;
            PG8_LDA(At, 0, 1); PG8_STAGE(PG8_SB(0, 0), b2, voffB); PG8_STAGE(PG8_SB(0, 1), b2 + hstepB, voffB); PG8_STAGE(PG8_SA(0, 0), a2, voffA);
            PG8_WAIT_V(8); PG8_WAIT_L(0); PG8_BAR; PG8_MMA(1, 0, At, B0); PG8_MMA(1, 1, At, B1); PG8_BAR; PG8_SCHED;
            PG8_LDB(B0, 1, 0); PG8_LDB(B1, 1, 1); PG8_SCHED; PG8_LDA(At, 1, 0); PG8_STAGE(PG8_SA(0, 1), a2 + hstepA, voffA);
            PG8_WAIT_V(8); PG8_WAIT_L(0); PG8_BAR; PG8_MMA(0, 0, At, B0); PG8_MMA(0, 1, At, B1); PG8_BAR; PG8_SCHED;
            PG8_LDA(At, 1, 1); PG8_STAGE(PG8_SB(1, 0), b3, voffB); PG8_STAGE(PG8_SB(1, 1), b3 + hstepB, voffB); PG8_STAGE(PG8_SA(1, 0), a3, voffA);
            PG8_WAIT_V(8); PG8_WAIT_L(0); PG8_BAR; PG8_MMA(1, 0, At, B0); PG8_MMA(1, 1, At, B1); PG8_BAR; PG8_SCHED;
            } else {
            PG8_LDB(B0, 0, 0); PG8_SCHED; PG8_LDA(At, 0, 0); PG8_STAGE(PG8_SA(1, 1), a1 + hstepA, voffA);
            PG8_WAIT_L(8); PG8_BAR; PG8_WAIT_L(0); PG8_MMA(0, 0, At, B0); PG8_BAR; PG8_SCHED;
            PG8_LDB(B1, 0, 1); PG8_STAGE(PG8_SB(0, 0), b2, voffB);
            PG8_BAR; PG8_WAIT_L(0); PG8_MMA(0, 1, At, B1); PG8_BAR;
            PG8_LDA(At, 0, 1); PG8_STAGE(PG8_SA(0, 0), a2, voffA);
            PG8_BAR; PG8_WAIT_L(0); PG8_MMA(1, 0, At, B0); PG8_BAR; PG8_SCHED;
            PG8_STAGE(PG8_SB(0, 1), b2 + hstepB, voffB);
            PG8_WAIT_V(6); PG8_BAR; PG8_MMA(1, 1, At, B1); PG8_BAR;
            PG8_LDB(B0, 1, 0); PG8_SCHED; PG8_LDA(At, 1, 0); PG8_STAGE(PG8_SA(0, 1), a2 + hstepA, voffA);
            PG8_WAIT_L(8); PG8_BAR; PG8_WAIT_L(0); PG8_MMA(0, 0, At, B0); PG8_BAR; PG8_SCHED;
            PG8_LDB(B1, 1, 1); PG8_STAGE(PG8_SB(1, 0), b3, voffB);
            PG8_BAR; PG8_WAIT_L(0); PG8_MMA(0, 1, At, B1); PG8_BAR;
            PG8_LDA(At, 1, 1); PG8_STAGE(PG8_SA(1, 0), a3, voffA);
            PG8_BAR; PG8_WAIT_L(0); PG8_MMA(1, 0, At, B0); PG8_BAR; PG8_SCHED;
            PG8_STAGE(PG8_SB(1, 1), b3 + hstepB, voffB);
            PG8_WAIT_V(6); PG8_BAR; PG8_MMA(1, 1, At, B1); PG8_BAR;
            }
        }
        if constexpr (ALIGN_EPI) { if (wr == 0) PG8_BAR; }
        E(acc, cur, wr, wc, fr, fq); S.done(cur);
        if (!has_next) break;
#pragma unroll
        for (int a = 0; a < 2; ++a)
#pragma unroll
            for (int b = 0; b < 2; ++b)
#pragma unroll
                for (int m = 0; m < 4; ++m)
#pragma unroll
                    for (int n = 0; n < 2; ++n) acc[a][b][m][n] = (f32x4){0.f, 0.f, 0.f, 0.f};
        cur = nxt; cA = nA; cB = nB; ++ui;
        if constexpr (ALIGN_EPI) { if (wr == 1) PG8_BAR; }
    }
    PG8_WAIT_V(0);
    if constexpr (!ALIGN_EPI) { if (wr == 0) PG8_BAR; }
    PG8_BAR;
#undef PG8_SA
#undef PG8_SB
#undef PG8_STAGE
#undef PG8_LDA
#undef PG8_LDB
#undef PG8_MMA
#undef PG8_WAIT_V
#undef PG8_WAIT_L
#undef PG8_BAR
#undef PG8_SCHED
}
}
#define GAS __attribute__((address_space(1)))
#define LAS __attribute__((address_space(3)))
typedef unsigned short bf16;
typedef unsigned v4u __attribute__((ext_vector_type(4)));
typedef float f32x4 __attribute__((ext_vector_type(4)));
typedef short bf16x8 __attribute__((ext_vector_type(8)));
typedef GAS unsigned gu32;
typedef GAS unsigned long long gu64;
#define RLX_AGENT __ATOMIC_RELAXED, __HIP_MEMORY_SCOPE_AGENT
#define LDS_WAIT() asm volatile("s_waitcnt lgkmcnt(0)" ::: "memory")
#define VM_WAIT() asm volatile("s_waitcnt vmcnt(0)" ::: "memory")
__device__ __forceinline__ unsigned long long rt() { return __builtin_amdgcn_s_memrealtime(); }
__device__ __forceinline__ unsigned f2bf(float f) { unsigned u = __builtin_bit_cast(unsigned, f); return (u + 0x7fffu + ((u >> 16) & 1u)) >> 16; }
__device__ __forceinline__ unsigned pk2(float lo, float hi) { return pg8::cvt_pk_bf16(lo, hi); }

#define XB_TMO      128
#define XB_XCNT(j)  (256  + 64 * (j))
#define XB_XSUB(j)  (1280 + 64 * (j))
#define XB_XGEN(j)  (2304 + 64 * (j))
#define XB_TOP      3328
#define XB_TOPGEN   3392
#define XCD_BAR_WORDS 3456
#define XB_SPIN_CAP (1u << 18)

__device__ __forceinline__ unsigned xb_ld(unsigned* p)              { return __hip_atomic_load(p, __ATOMIC_RELAXED, __HIP_MEMORY_SCOPE_AGENT); }
__device__ __forceinline__ unsigned xb_add(unsigned* p, unsigned v) { return __hip_atomic_fetch_add(p, v, __ATOMIC_RELAXED, __HIP_MEMORY_SCOPE_AGENT); }
__device__ __forceinline__ unsigned xb_xcc_id() { return (unsigned)__builtin_amdgcn_s_getreg((3 << 11) | 20) & 0xFu; }
#define XB_SPIN(cond, bar) do { unsigned _sp = 0; while (cond) { __builtin_amdgcn_s_sleep(1); \
    if ((++_sp & 255u) == 0u) { if (xb_ld(&(bar)[XB_TMO])) break; if (_sp > XB_SPIN_CAP) { atomicAdd(&(bar)[XB_TMO], 1u); break; } } } } while (0)

struct XcdBarrier {
    unsigned* bar; unsigned x;
    volatile LAS unsigned* st;
};

__device__ __forceinline__ XcdBarrier xcd_barrier_post(unsigned* bar, volatile LAS unsigned* st) {
    XcdBarrier b; b.bar = bar; b.x = xb_xcc_id(); b.st = st;
    if (threadIdx.x == 0) (void)xb_add(&bar[XB_XCNT(b.x)], 1u);
    return b;
}
__device__ __forceinline__ void xcd_barrier_complete(unsigned* bar, unsigned x, unsigned& nloc, unsigned& nx) {
    const unsigned G = gridDim.x * gridDim.y * gridDim.z;
    unsigned sum, cnt, mine, sp = 0u;
    for (;;) {
        sum = 0u; cnt = 0u; mine = 0u;
#pragma unroll
        for (unsigned j = 0; j < 16; ++j) { const unsigned c = xb_ld(&bar[XB_XCNT(j)]); sum += c; cnt += (c > 0u) ? 1u : 0u; mine = (j == x) ? c : mine; }
        if (sum == G) break;
        __builtin_amdgcn_s_sleep(1);
        if ((++sp & 255u) == 0u) { if (xb_ld(&bar[XB_TMO])) break; if (sp > XB_SPIN_CAP) { atomicAdd(&bar[XB_TMO], 1u); break; } }
    }
    nloc = mine > 0u ? mine : 1u; nx = cnt > 0u ? cnt : 1u;
}

__device__ __forceinline__ void xcd_barrier(const XcdBarrier& b) {
    asm volatile("s_waitcnt vmcnt(0)" ::: "memory");
    __syncthreads();
    if (threadIdx.x == 0) {
        unsigned* bar = b.bar;
        __builtin_amdgcn_s_waitcnt(0);
        unsigned nloc = b.st[0], nx = b.st[1];
        if (nloc == 0u) { xcd_barrier_complete(bar, b.x, nloc, nx); b.st[0] = nloc; b.st[1] = nx; }
        const unsigned old = xb_add(&bar[XB_XSUB(b.x)], 1u);
        const unsigned gen = old / nloc;
        if (old + 1u == (gen + 1u) * nloc) {
            __builtin_amdgcn_fence(__ATOMIC_RELEASE, "agent");
            asm volatile("s_waitcnt vmcnt(0)" ::: "memory");
            const unsigned og = xb_add(&bar[XB_TOP], 1u);
            const unsigned tg = og / nx;
            if (og + 1u == (tg + 1u) * nx) xb_add(&bar[XB_TOPGEN], 1u);
            else XB_SPIN(xb_ld(&bar[XB_TOPGEN]) == tg, bar);
            __builtin_amdgcn_fence(__ATOMIC_ACQUIRE, "agent");
            xb_add(&bar[XB_XGEN(b.x)], 1u);
            asm volatile("s_waitcnt vmcnt(0)" ::: "memory");
        } else {
            XB_SPIN(xb_ld(&bar[XB_XGEN(b.x)]) == gen, bar);
            __builtin_amdgcn_fence(__ATOMIC_ACQUIRE, "agent");
            asm volatile("s_waitcnt vmcnt(0)" ::: "memory");
        }
    }
    __syncthreads();
}

constexpr int DM = 2048, BATCH = 16, SEQ = 2048, DEPTH = 4, MTOK = BATCH * SEQ;
constexpr int INC = 11524;
constexpr int ZQ = 5376;
constexpr int GWD = 6144;
constexpr int N1 = ZQ + GWD;
constexpr int DFF = 8192;
constexpr int FB_COL = 3072;
constexpr float EPS = 1e-6f;
static_assert(ZQ == pg8::E_ZQ && GWD == pg8::E_GW && DM == pg8::E_DM && DFF == pg8::E_DFF, "shape constants");
constexpr int NWAVES = 8;

constexpr size_t MiB = 1u << 20;
constexpr size_t WS_CTL = 0, CTL_ZERO_BYTES = 1 * MiB;
constexpr size_t WS_WIN = 2 * MiB;
constexpr size_t WS_WUA = 47 * MiB;
constexpr size_t WS_WUB = 49 * MiB;
constexpr size_t WS_WUC = 51 * MiB;
constexpr size_t WS_WOUT = 54 * MiB;
constexpr size_t WS_WFI = 62 * MiB;
constexpr size_t WS_WFO = 94 * MiB;
constexpr size_t WS_LOGF = 126 * MiB;
constexpr size_t WS_CUM = 127 * MiB;
constexpr size_t WS_H = 128 * MiB;
constexpr size_t WS_OA = 256 * MiB;
constexpr size_t WS_OB = 288 * MiB;
constexpr size_t WS_OC = 320 * MiB;
constexpr size_t WS_ASCR = 368 * MiB;
constexpr size_t WS_Z = 400 * MiB;
constexpr size_t WS_G = 736 * MiB;
constexpr size_t WS_M32 = WS_Z;
constexpr size_t WS_U = WS_Z;
constexpr size_t WS_END = 1120 * MiB;
static_assert(WS_U + (size_t)MTOK * DFF * 2 <= WS_END && WS_G + (size_t)MTOK * GWD * 2 <= WS_END && WS_Z + (size_t)MTOK * ZQ * 2 <= WS_G && WS_M32 + (size_t)MTOK * DM * 4 <= WS_G, "d_ws map");
constexpr int CW_BAR = 4096;
constexpr int CW_QUEUE = 16384;

constexpr int RING_OFF = 0, RING_BYTES = 131072;
constexpr int EPI_OFF = RING_BYTES, EPI_BYTES = 8192;
constexpr int MISC_OFF = EPI_OFF + EPI_BYTES;
constexpr int LDS_BYTES = 147456;
static_assert(MISC_OFF + 256 <= LDS_BYTES, "LDS map");

constexpr int NPH = 9;

struct Frame {
    LAS unsigned char* lds;
    volatile LAS unsigned* MISC;
    gu32* ctl;
    int tid, lane, wave, vcu, G, bx;
    const float* in[23];
    float* out;
    unsigned char* ws;
};

__device__ __forceinline__ float wave_sum(float v) {
#pragma unroll
    for (int o = 1; o < 64; o <<= 1) v += __shfl_xor(v, o);
    return v;
}
__device__ __forceinline__ float wave_max(float v) {
#pragma unroll
    for (int o = 1; o < 64; o <<= 1) v = fmaxf(v, __shfl_xor(v, o));
    return v;
}
__device__ __forceinline__ float bflo(unsigned w) { return __uint_as_float(w << 16); }
__device__ __forceinline__ float bfhi(unsigned w) { return __uint_as_float(w & 0xffff0000u); }

__device__ __forceinline__ void transpose_item(const float* W, int ldw, int K, bf16* WT, int n0s, int n0d, int k0, LAS float* scr, int lane) {
#pragma unroll 8
    for (int i = 0; i < 32; ++i) { const int kk = 2 * i + (lane >> 5); scr[kk * 33 + (lane & 31)] = ((const GAS float*)W)[(size_t)(k0 + kk) * ldw + n0s + (lane & 31)]; }
    LDS_WAIT(); asm volatile("" ::: "memory");
    const int c = lane & 7;
#pragma unroll
    for (int j = 0; j < 4; ++j) { const int n = (lane >> 3) + 8 * j; const LAS float* s = scr + (8 * c) * 33 + n;
        v4u o; o.x = pk2(s[0 * 33], s[1 * 33]); o.y = pk2(s[2 * 33], s[3 * 33]); o.z = pk2(s[4 * 33], s[5 * 33]); o.w = pk2(s[6 * 33], s[7 * 33]);
        *(GAS v4u*)((GAS bf16*)WT + (size_t)(n0d + n) * K + k0 + 8 * c) = o; }
    LDS_WAIT(); asm volatile("" ::: "memory");
}
__device__ __forceinline__ bool transpose_pick(int& r, const float* W, int ldw, int K, int Ndst, int skip_at, int skip, bf16* WT, LAS float* scr, int lane) {
    const int nblk = Ndst / 32, items = (K / 64) * nblk;
    if (r >= items) { r -= items; return false; }
    const int kb = r / nblk, nb = r % nblk, n0d = 32 * nb, n0s = n0d + (n0d >= skip_at ? skip : 0);
    transpose_item(W, ldw, K, WT, n0s, n0d, 64 * kb, scr, lane);
    return true;
}
__device__ __forceinline__ void p_weights(Frame& F, int layer) {
    LAS float* scr = (LAS float*)(F.lds + RING_OFF + F.wave * 8448);
    const int gw = F.vcu * NWAVES + F.wave, NGW = F.G * NWAVES;
    const float* w_in = F.in[2] + (size_t)layer * DM * INC;
    const float* w_ua = F.in[16] + (size_t)layer * 512 * DM;
    const float* w_ub = F.in[17] + (size_t)layer * 512 * DM;
    const float* w_uc = F.in[18] + (size_t)layer * 768 * DM;
    const float* w_o = F.in[19] + (size_t)layer * DM * DM;
    const float* w_fi = F.in[21] + (size_t)layer * DM * DFF;
    const float* w_fo = F.in[22] + (size_t)layer * DFF * DM;
    constexpr int NITEMS = (DM / 64) * (N1 / 32) + 2 * (512 / 64) * (DM / 32) + (768 / 64) * (DM / 32) + (DM / 64) * (DM / 32) + (DM / 64) * (DFF / 32) + (DFF / 64) * (DM / 32);
    for (int it = gw; it < NITEMS; it += NGW) {
        int r = it;
        if (transpose_pick(r, w_in, INC, DM, N1, FB_COL, 4, (bf16*)(F.ws + WS_WIN), scr, F.lane)) continue;
        if (transpose_pick(r, w_ua, DM, 512, DM, 1 << 30, 0, (bf16*)(F.ws + WS_WUA), scr, F.lane)) continue;
        if (transpose_pick(r, w_ub, DM, 512, DM, 1 << 30, 0, (bf16*)(F.ws + WS_WUB), scr, F.lane)) continue;
        if (transpose_pick(r, w_uc, DM, 768, DM, 1 << 30, 0, (bf16*)(F.ws + WS_WUC), scr, F.lane)) continue;
        if (transpose_pick(r, w_o, DM, DM, DM, 1 << 30, 0, (bf16*)(F.ws + WS_WOUT), scr, F.lane)) continue;
        if (transpose_pick(r, w_fi, DFF, DM, DFF, 1 << 30, 0, (bf16*)(F.ws + WS_WFI), scr, F.lane)) continue;
        transpose_pick(r, w_fo, DM, DFF, DM, 1 << 30, 0, (bf16*)(F.ws + WS_WFO), scr, F.lane);
    }
}
template <bool FB, bool COPY>
__device__ __forceinline__ void p_norm(Frame& F, const float* X, const float* g, bf16* H, float* xcopy, const float* bfg, float* logf, const LAS float* wfb) {
    const int gw = F.vcu * NWAVES + F.wave, NGW = F.G * NWAVES, lane = F.lane;
    const GAS float* Xg = (const GAS float*)X; GAS float* xcg = (GAS float*)xcopy; GAS bf16* Hg = (GAS bf16*)H; GAS float* logfg = (GAS float*)logf;
    f32x4 gv[8];
#pragma unroll
    for (int j = 0; j < 8; ++j) gv[j] = *(const GAS f32x4*)((const GAS float*)g + 4 * lane + 256 * j);
    for (int m = gw; m < MTOK; m += NGW) {
        const GAS float* xr = Xg + (size_t)m * DM;
        f32x4 v[8]; float s = 0.f;
#pragma unroll
        for (int j = 0; j < 8; ++j) { v[j] = *(const GAS f32x4*)(xr + 4 * lane + 256 * j); s += (v[j][0] * v[j][0] + v[j][1] * v[j][1]) + (v[j][2] * v[j][2] + v[j][3] * v[j][3]); }
        if (COPY) {
#pragma unroll
            for (int j = 0; j < 8; ++j) *(GAS f32x4*)(xcg + (size_t)m * DM + 4 * lane + 256 * j) = v[j];
        }
        const float rstd = 1.0f / sqrtf(wave_sum(s) * (1.0f / DM) + EPS);
        float f0 = 0.f, f1 = 0.f, f2 = 0.f, f3 = 0.f;
#pragma unroll
        for (int j = 0; j < 8; ++j) { v[j] = v[j] * rstd * gv[j];
            if (FB) {
#pragma unroll
                for (int e = 0; e < 4; ++e) { const f32x4 w = *(const LAS f32x4*)(wfb + (size_t)(4 * lane + 256 * j + e) * 4); const float hv = v[j][e]; f0 += hv * w[0]; f1 += hv * w[1]; f2 += hv * w[2]; f3 += hv * w[3]; }
            }
            unsigned long long o = (unsigned long long)pk2(v[j][0], v[j][1]) | ((unsigned long long)pk2(v[j][2], v[j][3]) << 32);
            *(GAS unsigned long long*)(Hg + (size_t)m * DM + 4 * lane + 256 * j) = o;
            if (FB) asm volatile("" ::: "memory"); }
        if (FB) {
            f0 = wave_sum(f0); f1 = wave_sum(f1); f2 = wave_sum(f2); f3 = wave_sum(f3);
            if (lane < 4) { float z = (lane == 0 ? f0 : lane == 1 ? f1 : lane == 2 ? f2 : f3) + ((const GAS float*)bfg)[lane];
                const float ls = fminf(z, 0.f) - log1pf(expf(-fabsf(z)));
                logfg[(size_t)m * 4 + lane] = ls; }
        }
    }
}

__device__ __forceinline__ void p_prep(Frame& F, int layer) {
    const int gw = F.vcu * NWAVES + F.wave, NGW = F.G * NWAVES, lane = F.lane;
    GAS bf16* Z = (GAS bf16*)(F.ws + WS_Z);
    const float* gqa = F.in[5] + layer * 64; const float* gka = F.in[6] + layer * 64;
    const float* gqb = F.in[12] + layer * 128; const float* gkb = F.in[13] + layer * 128;
    const float* gqc = F.in[14] + layer * 128; const float* gkc = F.in[15] + layer * 128;
    f32x4 ga[7][2];
#pragma unroll
    for (int c = 0; c < 7; ++c) {
        const int cs = c == 0 ? 0 : c == 1 ? 512 : c == 2 ? 1536 : c == 3 ? 2048 : c == 4 ? 3072 : c == 5 ? 3584 : 4096;
        const int col = cs + 8 * lane; const float* gp; int idx;
        if (col < 512) { gp = gqa; idx = col & 63; } else if (col < 1024) { gp = gka; idx = col & 63; }
        else if (col < 2048) { gp = gqb; idx = (col - 1536) & 127; } else if (col < 2560) { gp = gkb; idx = (col - 2048) & 127; }
        else if (col < 3840) { gp = gqc; idx = (col - 3072) & 127; } else { gp = gkc; idx = (col - 3840) & 127; }
        ga[c][0] = *(const GAS f32x4*)((const GAS float*)gp + idx); ga[c][1] = *(const GAS f32x4*)((const GAS float*)gp + idx + 4);
    }
    for (int m = gw; m < MTOK; m += NGW) {
        GAS bf16* zr = Z + (size_t)m * ZQ;
#pragma unroll
        for (int c = 0; c < 7; ++c) {
            const int cs = c == 0 ? 0 : c == 1 ? 512 : c == 2 ? 1536 : c == 3 ? 2048 : c == 4 ? 3072 : c == 5 ? 3584 : 4096;
            const v4u w = *(const GAS v4u*)(zr + cs + 8 * lane);
            float v[8] = {bflo(w.x), bfhi(w.x), bflo(w.y), bfhi(w.y), bflo(w.z), bfhi(w.z), bflo(w.w), bfhi(w.w)};
            float ss = 0.f;
#pragma unroll
            for (int e = 0; e < 8; ++e) ss += v[e] * v[e];
            ss += __shfl_xor(ss, 1); ss += __shfl_xor(ss, 2); ss += __shfl_xor(ss, 4);
            float r;
            if (c < 2) r = 1.0f / sqrtf(ss * (1.0f / 64.0f) + EPS);
            else { ss += __shfl_xor(ss, 8); r = 1.0f / sqrtf(ss * (1.0f / 128.0f) + EPS); }
            v4u o;
            o.x = pk2(v[0] * r * ga[c][0][0], v[1] * r * ga[c][0][1]); o.y = pk2(v[2] * r * ga[c][0][2], v[3] * r * ga[c][0][3]);
            o.z = pk2(v[4] * r * ga[c][1][0], v[5] * r * ga[c][1][1]); o.w = pk2(v[6] * r * ga[c][1][2], v[7] * r * ga[c][1][3]);
            *(GAS v4u*)(zr + cs + 8 * lane) = o;
        }
    }
    if (gw < BATCH * 4) {
        const int b = gw >> 2, h = gw & 3; const GAS float* lf = (const GAS float*)(F.ws + WS_LOGF); GAS float* cum = (GAS float*)(F.ws + WS_CUM);
        float carry = 0.f;
        for (int ch = 0; ch < SEQ / 64; ++ch) {
            const size_t idx = ((size_t)b * SEQ + ch * 64 + lane) * 4 + h;
            float v = lf[idx];
#pragma unroll
            for (int o = 1; o < 64; o <<= 1) { const float t = __shfl_up(v, o); if (lane >= o) v += t; }
            v += carry; cum[idx] = v; carry = __shfl(v, 63);
        }
    }
}

__device__ __forceinline__ float dot8(v4u w, const LAS float* q) {
    const f32x4 q0 = *(const LAS f32x4*)q, q1 = *(const LAS f32x4*)(q + 4);
    return (bflo(w.x) * q0[0] + bfhi(w.x) * q0[1]) + (bflo(w.y) * q0[2] + bfhi(w.y) * q0[3]) + (bflo(w.z) * q1[0] + bfhi(w.z) * q1[1]) + (bflo(w.w) * q1[2] + bfhi(w.w) * q1[3]);
}
__device__ __forceinline__ void p_attn_naive(Frame& F, int layer) {
    const int gw = F.vcu * NWAVES + F.wave, NGW = F.G * NWAVES, lane = F.lane;
    LAS float* S0 = (LAS float*)(F.lds + RING_OFF + F.wave * 16384);
    LAS float* S1 = S0 + 2048;
    LAS float* qs = (LAS float*)(F.lds + EPI_OFF + F.wave * 1024);
    const GAS bf16* Z = (const GAS bf16*)(F.ws + WS_Z);
    const GAS float* cum = (const GAS float*)(F.ws + WS_CUM);
    GAS bf16* OA = (GAS bf16*)(F.ws + WS_OA); GAS bf16* OB = (GAS bf16*)(F.ws + WS_OB); GAS bf16* OC = (GAS bf16*)(F.ws + WS_OC);
    const float lam_init = 0.8f - 0.6f * expf(-0.3f * (float)layer);
    const float lam = expf(wave_sum(F.in[7][layer * 64 + lane] * F.in[8][layer * 64 + lane])) - expf(wave_sum(F.in[9][layer * 64 + lane] * F.in[10][layer * 64 + lane])) + lam_init;
    const float* gsub = F.in[11] + layer * 128;
    const float NEG = -__builtin_inff();
    for (int task = gw; task < MTOK * 14; task += NGW) {
        const int row = task / 14, hd = task - row * 14, b = row >> 11, t = row & 2047, r0 = b << 11;
        const GAS bf16* zr = Z + (size_t)row * ZQ;
        if (hd < 4) {
            const int h = hd; const float slope = exp2f(-2.0f * (float)(h + 1));
            { const unsigned w = *(const GAS unsigned*)(zr + h * 128 + 2 * lane); qs[2 * lane] = bflo(w); qs[2 * lane + 1] = bfhi(w); asm volatile("" ::: "memory"); }
            float m0 = NEG, m1 = NEG;
            for (int j = lane; j <= t; j += 64) {
                const GAS bf16* kr = Z + (size_t)(r0 + j) * ZQ + 512 + h * 128;
                float s0 = 0.f, s1 = 0.f;
#pragma unroll
                for (int c = 0; c < 8; ++c) s0 += dot8(*(const GAS v4u*)(kr + c * 8), qs + c * 8);
#pragma unroll
                for (int c = 8; c < 16; ++c) s1 += dot8(*(const GAS v4u*)(kr + c * 8), qs + c * 8);
                const float bias = -slope * (float)(t - j);
                s0 = s0 * 0.125f + bias; s1 = s1 * 0.125f + bias;
                S0[j] = s0; S1[j] = s1; m0 = fmaxf(m0, s0); m1 = fmaxf(m1, s1);
            }
            m0 = wave_max(m0); m1 = wave_max(m1);
            float l0 = 0.f, l1 = 0.f;
            for (int j = lane; j <= t; j += 64) { const float e0 = expf(S0[j] - m0), e1 = expf(S1[j] - m1); S0[j] = e0; S1[j] = e1; l0 += e0; l1 += e1; }
            l0 = wave_sum(l0); l1 = wave_sum(l1);
            const float i0 = 1.0f / l0, i1 = lam / l1;
            for (int j = lane; j <= t; j += 64) S0[j] = S0[j] * i0 - S1[j] * i1;
            float a0 = 0.f, a1 = 0.f; const GAS bf16* vb = Z + (size_t)r0 * ZQ + 1024 + h * 128 + 2 * lane;
            for (int j = 0; j <= t; ++j) { const float p = S0[j]; const unsigned w = *(const GAS unsigned*)(vb + (size_t)j * ZQ); a0 += p * bflo(w); a1 += p * bfhi(w); }
            const float ss = wave_sum(a0 * a0 + a1 * a1);
            const float r = (1.0f / sqrtf(ss * (1.0f / 128.0f) + EPS));
            const float o0 = a0 * r * gsub[2 * lane] * (1.0f - lam_init), o1 = a1 * r * gsub[2 * lane + 1] * (1.0f - lam_init);
            *(GAS unsigned*)(OA + (size_t)row * 512 + h * 128 + 2 * lane) = pk2(o0, o1);
        } else if (hd < 8) {
            const int h = hd - 4;
            { const unsigned w = *(const GAS unsigned*)(zr + 1536 + h * 128 + 2 * lane); qs[2 * lane] = bflo(w); qs[2 * lane + 1] = bfhi(w); asm volatile("" ::: "memory"); }
            const float ct = cum[(size_t)row * 4 + h];
            float m0 = NEG;
            for (int j = lane; j <= t; j += 64) {
                const GAS bf16* kr = Z + (size_t)(r0 + j) * ZQ + 2048 + h * 128;
                float s0 = 0.f;
#pragma unroll
                for (int c = 0; c < 16; ++c) s0 += dot8(*(const GAS v4u*)(kr + c * 8), qs + c * 8);
                s0 = s0 * 0.08838834764831845f + (ct - cum[(size_t)(r0 + j) * 4 + h]);
                S0[j] = s0; m0 = fmaxf(m0, s0);
            }
            m0 = wave_max(m0);
            float l0 = 0.f;
            for (int j = lane; j <= t; j += 64) { const float e0 = expf(S0[j] - m0); S0[j] = e0; l0 += e0; }
            l0 = wave_sum(l0);
            float a0 = 0.f, a1 = 0.f; const GAS bf16* vb = Z + (size_t)r0 * ZQ + 2560 + h * 128 + 2 * lane;
            for (int j = 0; j <= t; ++j) { const float p = S0[j]; const unsigned w = *(const GAS unsigned*)(vb + (size_t)j * ZQ); a0 += p * bflo(w); a1 += p * bfhi(w); }
            const float il = 1.0f / l0;
            *(GAS unsigned*)(OB + (size_t)row * 512 + h * 128 + 2 * lane) = pk2(a0 * il, a1 * il);
        } else {
            const int h = hd - 8; const float slope = exp2f(-8.0f * (float)(h + 1) / 6.0f);
            { const unsigned w = *(const GAS unsigned*)(zr + 3072 + h * 128 + 2 * lane); qs[2 * lane] = bflo(w); qs[2 * lane + 1] = bfhi(w); asm volatile("" ::: "memory"); }
            float po0[3], po1[3], pm[3], pl[3];
#pragma unroll
            for (int p = 0; p < 3; ++p) {
                const int d = 1 << (2 * p); const int nk = (t / d < 128 ? t / d : 128) + 1;
                float mx = NEG;
                for (int j = lane; j < nk; j += 64) {
                    const GAS bf16* kr = Z + (size_t)(r0 + t - d * j) * ZQ + 3840 + h * 128;
                    float s0 = 0.f;
#pragma unroll
                    for (int c = 0; c < 16; ++c) s0 += dot8(*(const GAS v4u*)(kr + c * 8), qs + c * 8);
                    s0 = s0 * 0.08838834764831845f - slope * (float)(d * j);
                    S0[j] = s0; mx = fmaxf(mx, s0);
                }
                mx = wave_max(mx);
                float l = 0.f;
                for (int j = lane; j < nk; j += 64) { const float e = expf(S0[j] - mx); S0[j] = e; l += e; }
                l = wave_sum(l);
                float a0 = 0.f, a1 = 0.f; const GAS bf16* vb = Z + (size_t)(r0 + t) * ZQ + 4608 + h * 128 + 2 * lane;
                for (int j = 0; j < nk; ++j) { const float pp = S0[j]; const unsigned w = *(const GAS unsigned*)(vb - (size_t)(d * j) * ZQ); a0 += pp * bflo(w); a1 += pp * bfhi(w); }
                po0[p] = a0 / l; po1[p] = a1 / l; pm[p] = mx; pl[p] = l;
            }
            const float mtop = fmaxf(pm[0], fmaxf(pm[1], pm[2]));
            const float w0 = pl[0] * expf(pm[0] - mtop), w1 = pl[1] * expf(pm[1] - mtop), w2 = pl[2] * expf(pm[2] - mtop);
            const float iw = 1.0f / (w0 + w1 + w2);
            *(GAS unsigned*)(OC + (size_t)row * 768 + h * 128 + 2 * lane) = pk2((w0 * po0[0] + w1 * po0[1] + w2 * po0[2]) * iw, (w0 * po1[0] + w1 * po1[1] + w2 * po1[2]) * iw);
        }
    }
}
#ifndef MK_PER_PHASE
#define MK_PER_PHASE 0
#endif
struct Args { const float* in[23]; float* out; unsigned char* ws; int gp_lo, gp_hi; };
__global__ void __launch_bounds__(NWAVES * 64, 2) mk_fwd(Args args) {
    extern __shared__ __attribute__((aligned(16))) unsigned char lds[];
    Frame F;
    F.lds = (LAS unsigned char*)lds;
    F.MISC = (volatile LAS unsigned*)(F.lds + MISC_OFF);
    F.tid = threadIdx.x; F.lane = F.tid & 63; F.wave = __builtin_amdgcn_readfirstlane(F.tid >> 6);
    F.G = gridDim.x; F.bx = blockIdx.x; F.vcu = (F.G % 8 == 0) ? (F.bx % 8) * (F.G / 8) + F.bx / 8 : F.bx;
    F.ws = args.ws; F.out = args.out; F.ctl = (gu32*)(args.ws + WS_CTL);
#pragma unroll
    for (int i = 0; i < 23; ++i) F.in[i] = args.in[i];
    if (F.tid < 64) ((LAS unsigned*)(F.lds + MISC_OFF))[F.tid] = 0u;
    __syncthreads();
    XcdBarrier bar; bar.bar = (unsigned*)(F.ctl + CW_BAR); bar.x = 0; bar.st = nullptr;
    if (!MK_PER_PHASE) bar = xcd_barrier_post((unsigned*)(F.ctl + CW_BAR), F.MISC + 8);
    const int lo = args.gp_lo, hi = args.gp_hi;
#define IN(k) (lo <= (k) && (k) < hi)
#define PH_ENTER() do { asm volatile("" : "+v"(F.tid), "+s"(F.bx), "+s"(F.ws), "+s"(F.out)); F.lane = F.tid & 63; F.wave = __builtin_amdgcn_readfirstlane(F.tid >> 6); \
    F.vcu = (F.G % 8 == 0) ? (F.bx % 8) * (F.G / 8) + F.bx / 8 : F.bx; } while (0)
#define SEAM(k) do { if ((k) + 1 < hi) { if (MK_PER_PHASE) { if (F.tid == 0) __hip_atomic_store(F.ctl + 0, 0xBADBA0u, RLX_AGENT); } else xcd_barrier(bar); } } while (0)

#define Hb ((bf16*)(F.ws + WS_H))
    for (int layer = 0; layer < DEPTH; ++layer) {
        const int gp = layer * NPH;
        if (IN(gp + 0)) { PH_ENTER();
            LAS float* wfb = (LAS float*)(F.lds + 98304);
            { const float* w_in = F.in[2] + (size_t)layer * DM * INC;
              for (int k = F.tid; k < DM; k += NWAVES * 64) *(LAS f32x4*)(wfb + 4 * k) = *(const GAS f32x4*)((const GAS float*)w_in + (size_t)k * INC + FB_COL); }
            p_weights(F, layer);
            __syncthreads();
            const float* g = F.in[1] + layer * DM; const float* bfg = F.in[3] + layer * 4; float* logf = (float*)(F.ws + WS_LOGF);
            if (layer == 0) p_norm<true, true>(F, F.in[0], g, Hb, F.out, bfg, logf, wfb);
            else p_norm<true, false>(F, F.out, g, Hb, nullptr, bfg, logf, wfb);
            __syncthreads();
            SEAM(gp + 0);
        }
        if (IN(gp + 1)) { PH_ENTER();
            pg8::Gemm g{Hb, (const bf16*)(F.ws + WS_WIN), MTOK, N1, DM, DM}; pg8::StaticOrder S; S.init(MTOK, N1, F.G, F.bx);
            pg8::EpiZ E{(bf16*)(F.ws + WS_Z), (bf16*)(F.ws + WS_G), F.in[4] + (size_t)layer * GWD};
            pg8::gemm_phase<pg8::EpiZ, pg8::StaticOrder, true, true>(F.lds + RING_OFF, g, S, E, F.tid);
            SEAM(gp + 1);
        }
        if (IN(gp + 2)) { PH_ENTER(); p_prep(F, layer); SEAM(gp + 2); }
        if (IN(gp + 3)) { PH_ENTER();
#if defined(DBG_ATTN_FILL)
            { const int gw = F.vcu * NWAVES + F.wave, NGW = F.G * NWAVES; const GAS bf16* Z = (const GAS bf16*)(F.ws + WS_Z);
              for (int m = gw; m < MTOK; m += NGW) { const GAS bf16* zr = Z + (size_t)m * ZQ;
                  *(GAS v4u*)((GAS bf16*)(F.ws + WS_OA) + (size_t)m * 512 + 8 * F.lane) = *(const GAS v4u*)(zr + 1024 + 8 * F.lane);
                  *(GAS v4u*)((GAS bf16*)(F.ws + WS_OB) + (size_t)m * 512 + 8 * F.lane) = *(const GAS v4u*)(zr + 2560 + 8 * F.lane);
                  *(GAS v4u*)((GAS bf16*)(F.ws + WS_OC) + (size_t)m * 768 + 8 * F.lane) = *(const GAS v4u*)(zr + 4608 + 8 * F.lane);
                  if (F.lane < 32) *(GAS v4u*)((GAS bf16*)(F.ws + WS_OC) + (size_t)m * 768 + 512 + 8 * F.lane) = *(const GAS v4u*)(zr + 4608 + 512 + 8 * F.lane); } }
#else
            p_attn_naive(F, layer);
#endif
            __syncthreads(); SEAM(gp + 3); }
        if (IN(gp + 4)) { PH_ENTER();
#define Gt ((const bf16*)(F.ws + WS_G))
#define M32 ((float*)(F.ws + WS_M32))
#if defined(DBG_MERGE_ONE)
            { pg8::Gemm g{(const bf16*)(F.ws + WS_OC), (const bf16*)(F.ws + WS_WUC), MTOK, DM, 768, 768}; pg8::StaticOrder S; S.init(MTOK, DM, F.G, F.bx);
              pg8::EpiMerge<DBG_MERGE_ONE> E{Gt, 2 * DM, M32, Hb}; pg8::gemm_phase<pg8::EpiMerge<DBG_MERGE_ONE>, pg8::StaticOrder, true, true>(F.lds + RING_OFF, g, S, E, F.tid); }
#else
            { pg8::Gemm g{(const bf16*)(F.ws + WS_OA), (const bf16*)(F.ws + WS_WUA), MTOK, DM, 512, 512}; pg8::StaticOrder S; S.init(MTOK, DM, F.G, F.bx);
              pg8::EpiMerge<0> E{Gt, 0, M32, Hb}; pg8::gemm_phase<pg8::EpiMerge<0>, pg8::StaticOrder, true, true>(F.lds + RING_OFF, g, S, E, F.tid); }
            PH_ENTER();
            { pg8::Gemm g{(const bf16*)(F.ws + WS_OB), (const bf16*)(F.ws + WS_WUB), MTOK, DM, 512, 512}; pg8::StaticOrder S; S.init(MTOK, DM, F.G, F.bx);
              pg8::EpiMerge<1> E{Gt, DM, M32, Hb}; pg8::gemm_phase<pg8::EpiMerge<1>, pg8::StaticOrder, true, true>(F.lds + RING_OFF, g, S, E, F.tid); }
            PH_ENTER();
            { pg8::Gemm g{(const bf16*)(F.ws + WS_OC), (const bf16*)(F.ws + WS_WUC), MTOK, DM, 768, 768}; pg8::StaticOrder S; S.init(MTOK, DM, F.G, F.bx);
              pg8::EpiMerge<2> E{Gt, 2 * DM, M32, Hb}; pg8::gemm_phase<pg8::EpiMerge<2>, pg8::StaticOrder, true, true>(F.lds + RING_OFF, g, S, E, F.tid); }
#endif
            SEAM(gp + 4);
        }
        if (IN(gp + 5)) { PH_ENTER();
            pg8::Gemm g{Hb, (const bf16*)(F.ws + WS_WOUT), MTOK, DM, DM, DM}; pg8::StaticOrder S; S.init(MTOK, DM, F.G, F.bx);
            pg8::EpiResid E{F.out, DM};
            pg8::gemm_phase<pg8::EpiResid, pg8::StaticOrder, true, true>(F.lds + RING_OFF, g, S, E, F.tid);
            SEAM(gp + 5);
        }
        if (IN(gp + 6)) { PH_ENTER(); p_norm<false, false>(F, F.out, F.in[20] + layer * DM, Hb, nullptr, nullptr, nullptr, nullptr); SEAM(gp + 6); }
        if (IN(gp + 7)) { PH_ENTER();
            pg8::Gemm g{Hb, (const bf16*)(F.ws + WS_WFI), MTOK, DFF, DM, DM}; pg8::StaticOrder S; S.init(MTOK, DFF, F.G, F.bx);
            pg8::EpiRelu2 E{(bf16*)(F.ws + WS_U), DFF};
            pg8::gemm_phase<pg8::EpiRelu2, pg8::StaticOrder, true, true>(F.lds + RING_OFF, g, S, E, F.tid);
            SEAM(gp + 7);
        }
        if (IN(gp + 8)) { PH_ENTER();
            pg8::Gemm g{(const bf16*)(F.ws + WS_U), (const bf16*)(F.ws + WS_WFO), MTOK, DM, DFF, DFF}; pg8::StaticOrder S; S.init(MTOK, DM, F.G, F.bx);
            pg8::EpiResid E{F.out, DM};
            pg8::gemm_phase<pg8::EpiResid, pg8::StaticOrder, true, true>(F.lds + RING_OFF, g, S, E, F.tid);
            SEAM(gp + 8);
        }
    }
#undef IN
#undef SEAM
#undef Hb
#undef Gt
#undef M32
}

#if defined(DBG_STOP_AFTER)
__global__ void dbg_dump_bf16(const unsigned short* src, size_t n, float* out, size_t total) {
    for (size_t i = (size_t)blockIdx.x * blockDim.x + threadIdx.x; i < total; i += (size_t)gridDim.x * blockDim.x) out[i] = i < n ? __uint_as_float((unsigned)src[i] << 16) : 0.f;
}
#endif
extern "C" void kernel_launch(void* const* d_in, const int* in_sizes, int n_in, void* d_out, int out_size, void* d_ws, size_t ws_size, hipStream_t stream) {
    static int grid = 0;
    if (grid == 0) {
        if (n_in != 23 || in_sizes[0] != MTOK * DM || out_size != MTOK * DM || ws_size < WS_END) { fprintf(stderr, "kernel_launch: unexpected shapes (n_in %d, in0 %d, out %d, ws %zu < %zu); nothing launched\n", n_in, n_in > 0 ? in_sizes[0] : -1, out_size, ws_size, (size_t)WS_END); grid = -1; return; }
        int dev = 0, cus = 0, per_cu = 0;
        if (hipGetDevice(&dev) != hipSuccess || hipDeviceGetAttribute(&cus, hipDeviceAttributeMultiprocessorCount, dev) != hipSuccess) { grid = -1; return; }
        if (hipFuncSetAttribute((const void*)mk_fwd, hipFuncAttributeMaxDynamicSharedMemorySize, LDS_BYTES) != hipSuccess) { fprintf(stderr, "kernel_launch: hipFuncSetAttribute failed\n"); grid = -1; return; }
        if (hipOccupancyMaxActiveBlocksPerMultiprocessor(&per_cu, (const void*)mk_fwd, NWAVES * 64, LDS_BYTES) != hipSuccess || per_cu < 1)
            fprintf(stderr, "kernel_launch: note: occupancy query reports %d workgroups per CU\n", per_cu);
        (void)hipGetLastError();
        grid = cus;
    }
    if (grid < 0) return;
    if (hipMemsetAsync((char*)d_ws + WS_CTL, 0, CTL_ZERO_BYTES, stream) != hipSuccess) { fprintf(stderr, "kernel_launch: memset failed\n"); return; }
    Args a{};
    for (int i = 0; i < 23; ++i) a.in[i] = (const float*)d_in[i];
    a.out = (float*)d_out; a.ws = (unsigned char*)d_ws;
#if MK_PER_PHASE
#if defined(DBG_STOP_AFTER)
    for (int gp = 0; gp <= DBG_STOP_AFTER; ++gp) { a.gp_lo = gp; a.gp_hi = gp + 1; hipLaunchKernelGGL(mk_fwd, dim3(grid), dim3(NWAVES * 64), LDS_BYTES, stream, a); }
    hipLaunchKernelGGL(dbg_dump_bf16, dim3(2048), dim3(256), 0, stream, (const unsigned short*)((const char*)d_ws + (size_t)(DBG_DUMP_OFF)), (size_t)(DBG_DUMP_N), (float*)d_out, (size_t)MTOK * DM);
#else
    for (int gp = 0; gp < DEPTH * NPH; ++gp) { a.gp_lo = gp; a.gp_hi = gp + 1; hipLaunchKernelGGL(mk_fwd, dim3(grid), dim3(NWAVES * 64), LDS_BYTES, stream, a); }
#endif
#else
    a.gp_lo = 0; a.gp_hi = DEPTH * NPH;
    hipLaunchKernelGGL(mk_fwd, dim3(grid), dim3(NWAVES * 64), LDS_BYTES, stream, a);
#endif
    const hipError_t le = hipPeekAtLastError();
    if (le != hipSuccess) fprintf(stderr, "kernel_launch: launch failed: %s\n", hipGetErrorName(le));
}
```

```cpp
#include <hip/hip_runtime.h>
#include <cstdio>
#include <cstdint>
namespace pg8 {
#define PG8_LAS __attribute__((address_space(3)))
typedef unsigned short bf16_t;
typedef short bf16x8 __attribute__((ext_vector_type(8)));
typedef float f32x4 __attribute__((ext_vector_type(4)));
typedef unsigned u32x4 __attribute__((ext_vector_type(4)));
constexpr int BM = 256, BK = 64, HALF = 128, HTB = HALF * BK * 2  , STAGE_BYTES = 8 * HTB, NXCD = 8, WGM = 8;

__host__ __device__ __forceinline__ int lds_byte(int r, int c) { const int st = (r >> 4) * 2 + (c >> 5), rr = r & 15, cc = c & 31, ob = rr * 64 + cc * 2; return st * 1024 + (ob ^ (((ob >> 9) & 1) << 5)); }
__host__ __device__ __forceinline__ void stage_rc(int b, int& R, int& C) { const int st = b / 1024, sb = b % 1024, swz = sb ^ (((sb >> 9) & 1) << 5); R = (st >> 1) * 16 + swz / 64; C = (st & 1) * 32 + (swz % 64) / 2; }
__host__ __device__ __forceinline__ int perm32(int rho) { const int n = rho >> 4, i = rho & 15; return 8 * (i >> 2) + 4 * n + (i & 3); }

struct Unit { int pm, pn; };
struct Gemm { const bf16_t* A; const bf16_t* Bt; int M, N, K, lda; };

struct StaticOrder {
    int nM, nN, nwg, G, c, wgm;
    __host__ __device__ void init(int M, int N, int G_, int c_, int wgm_ = WGM) { nM = M / BM; nN = N / BM; nwg = nM * nN; G = G_; c = c_; wgm = wgm_; }
    int bal_rounds = 1 << 30, bal_from = 0;
    __host__ __device__ bool next(int i, Unit& u) const {
        long L;
        if (i < bal_rounds) L = (long)i * G + c;
        else { if (c < bal_from) return false; L = (long)bal_rounds * G + (long)(i - bal_rounds) * (G - bal_from) + (c - bal_from); }
        if (L >= nwg) return false;
        int wgid = (int)L; { const int q = nwg / NXCD, r = nwg % NXCD, xcd = wgid % NXCD, off = wgid / NXCD; wgid = (xcd < r ? xcd * (q + 1) : r * (q + 1) + (xcd - r) * q) + off; }
        const int nig = wgm * nN, gid = wgid / nig, fm = gid * wgm, gsz = (nM - fm) < wgm ? (nM - fm) : wgm;
        u.pm = fm + ((wgid % nig) % gsz); u.pn = (wgid % nig) / gsz; return true;
    }
    __device__ __forceinline__ void a_ready(const Unit&) const {}
    __device__ __forceinline__ void done(const Unit&) const {}
};

typedef __bf16 bf16x2_t __attribute__((ext_vector_type(2)));
typedef float f32x2_t __attribute__((ext_vector_type(2)));
__device__ __forceinline__ unsigned cvt_pk_bf16(float lo, float hi) { const f32x2_t v = {lo, hi}; return __builtin_bit_cast(unsigned, __builtin_convertvector(v, bf16x2_t)); }
#define PG8_GAS __attribute__((address_space(1)))
__device__ __forceinline__ u32x4 pack8(f32x4 v0, f32x4 v1) { u32x4 w; w.x = cvt_pk_bf16(v0[0], v0[1]); w.y = cvt_pk_bf16(v0[2], v0[3]); w.z = cvt_pk_bf16(v1[0], v1[1]); w.w = cvt_pk_bf16(v1[2], v1[3]); return w; }
__device__ __forceinline__ float sigm(float v) { return __builtin_amdgcn_rcpf(1.0f + __builtin_amdgcn_exp2f(-1.4426950408889634f * v)); }
__device__ __forceinline__ float sigm255(float v) { const float e = __builtin_amdgcn_exp2f(-1.4426950408889634f * v); return fmaxf(__builtin_amdgcn_rcpf(__builtin_fmaf(e, 1.0f / 255.0f, 1.0f / 255.0f)), 1.0f); }
__device__ __forceinline__ float sigm255n(float a, float nl  , float nb) { const float e = __builtin_amdgcn_exp2f(__builtin_fmaf(a, nl, nb)); return fmaxf(__builtin_amdgcn_rcpf(__builtin_fmaf(e, 1.0f / 255.0f, 1.0f / 255.0f)), 1.0f); }
__device__ __forceinline__ float ubyte(unsigned w, int j) { return (float)((w >> (8 * j)) & 0xffu); }

constexpr int E_ZQ = 5376, E_GW = 6144, E_DM = 2048, E_DFF = 8192;

template <int SEG> __device__ __forceinline__ void qknorm_store(const f32x4 (&acc)[2][2][4][2], const Unit& u, int wr, int wc, int fr, int fq, PG8_LAS float* P, const PG8_LAS float* gain, bf16_t* Z) {
    float ss[2][4][2];
#pragma unroll
    for (int ai = 0; ai < 2; ++ai)
#pragma unroll
        for (int m = 0; m < 4; ++m)
#pragma unroll
            for (int bj = 0; bj < 2; ++bj) { const f32x4 a = acc[ai][bj][m][0], b = acc[ai][bj][m][1];
                float s = (a[0] * a[0] + a[1] * a[1]) + (a[2] * a[2] + a[3] * a[3]) + (b[0] * b[0] + b[1] * b[1]) + (b[2] * b[2] + b[3] * b[3]);
                s += __int_as_float(__builtin_amdgcn_ds_swizzle(__float_as_int(s), (16 << 10) | 0x1f));
                auto rr = __builtin_amdgcn_permlane32_swap(__float_as_uint(s), __float_as_uint(s), false, false);
                ss[ai][m][bj] = __uint_as_float(rr[0]) + __uint_as_float(rr[1]); }
    if (fq == 0) {
#pragma unroll
        for (int ai = 0; ai < 2; ++ai)
#pragma unroll
            for (int m = 0; m < 4; ++m)
#pragma unroll
                for (int bj = 0; bj < 2; ++bj) P[((ai * HALF + wr * 64 + m * 16 + fr) * 2 + bj) * 4 + wc] = ss[ai][m][bj];
    }
    asm volatile("s_waitcnt lgkmcnt(0)" ::: "memory"); __builtin_amdgcn_s_barrier(); asm volatile("" ::: "memory");
    const int gidx = (32 * wc + 8 * fq) & (SEG - 1);
    const f32x4 ga0 = *(const PG8_LAS f32x4*)(gain + gidx), ga1 = *(const PG8_LAS f32x4*)(gain + gidx + 4);
    const int row0 = u.pm * BM + wr * 64 + fr, col0 = u.pn * BM + wc * 32 + 8 * fq;
#pragma unroll
    for (int ai = 0; ai < 2; ++ai)
#pragma unroll
        for (int m = 0; m < 4; ++m) { PG8_GAS bf16_t* rowp = (PG8_GAS bf16_t*)Z + (size_t)(row0 + ai * HALF + m * 16) * E_ZQ + col0;
#pragma unroll
            for (int bj = 0; bj < 2; ++bj) { const f32x4 q = *(const PG8_LAS f32x4*)(P + ((ai * HALF + wr * 64 + m * 16 + fr) * 2 + bj) * 4);
                const float tot = SEG == 128 ? (q[0] + q[1]) + (q[2] + q[3]) : (wc < 2 ? q[0] + q[1] : q[2] + q[3]);
                const float r = 1.0f / sqrtf(tot * (1.0f / SEG) + 1e-6f);
                *(PG8_GAS u32x4*)(rowp + bj * HALF) = pack8(acc[ai][bj][m][0] * r * ga0, acc[ai][bj][m][1] * r * ga1); } }
}
struct EpiZ {
    static constexpr bool PERM = true, AFTER_DRAIN = false;
    bf16_t* Z; bf16_t* Gt; const float* bgate; PG8_LAS float* P; const PG8_LAS float* gains;
    __device__ __forceinline__ void operator()(const f32x4 (&acc)[2][2][4][2], const Unit& u, int wr, int wc, int fr, int fq) const {
        const int pn = u.pn < 4 ? u.pn : u.pn < 8 ? u.pn + 2 : u.pn + 4; Unit uz = u; uz.pn = pn;
        const int row0 = u.pm * BM + wr * 64 + fr; const int colt = pn * BM;
        if (colt < E_ZQ) {
            if (pn < 4) qknorm_store<64>(acc, uz, wr, wc, fr, fq, P, gains + (pn >> 1) * 128, Z);
            else if ((pn >= 6 && pn < 10) || (pn >= 12 && pn < 18)) qknorm_store<128>(acc, uz, wr, wc, fr, fq, P, gains + (pn < 8 ? 2 : pn < 10 ? 3 : pn < 15 ? 4 : 5) * 128, Z);
            else {
                const int col0 = colt + wc * 32 + 8 * fq;
#pragma unroll
                for (int ai = 0; ai < 2; ++ai)
#pragma unroll
                    for (int m = 0; m < 4; ++m) { PG8_GAS bf16_t* rowp = (PG8_GAS bf16_t*)Z + (size_t)(row0 + ai * HALF + m * 16) * E_ZQ + col0;
#pragma unroll
                        for (int bj = 0; bj < 2; ++bj) *(PG8_GAS u32x4*)(rowp + bj * HALF) = pack8(acc[ai][bj][m][0], acc[ai][bj][m][1]); }
            }
        } else {
            const int gc0 = colt - E_ZQ + wc * 32 + 8 * fq;
            f32x4 bv[2][2];
#pragma unroll
            for (int bj = 0; bj < 2; ++bj)
#pragma unroll
                for (int n = 0; n < 2; ++n) bv[bj][n] = *(const PG8_GAS f32x4*)((const PG8_GAS float*)bgate + gc0 + bj * HALF + 4 * n) * -1.4426950408889634f;
            PG8_GAS char* gp = (PG8_GAS char*)Gt + ((size_t)(u.pm * 24 + ((colt - E_ZQ) >> 8)) << 16) + (size_t)((wr * 4 + wc) * 1024) + (unsigned)((fq * 16 + fr) * 16);
#pragma unroll
            for (int ai = 0; ai < 2; ++ai)
#pragma unroll
                for (int m = 0; m < 4; ++m) { u32x4 w;
#pragma unroll
                    for (int bj = 0; bj < 2; ++bj) { unsigned w0 = 0u, w1 = 0u;
#pragma unroll
                        for (int j = 0; j < 4; ++j) { w0 = __builtin_amdgcn_cvt_pk_u8_f32(sigm255n(acc[ai][bj][m][0][j], -1.4426950408889634f, bv[bj][0][j]), j, w0); w1 = __builtin_amdgcn_cvt_pk_u8_f32(sigm255n(acc[ai][bj][m][1][j], -1.4426950408889634f, bv[bj][1][j]), j, w1); }
                        w[2 * bj] = w0; w[2 * bj + 1] = w1; }
                    __builtin_nontemporal_store(w, (PG8_GAS u32x4*)(gp + (ai * 4 + m) * 8192)); }
        }
    }
};
typedef int i32x4 __attribute__((ext_vector_type(4)));
struct EpiG8 {
    static constexpr bool PERM = true, AFTER_DRAIN = false, I8 = true;
    bf16_t* Gt; const float* bgate; const float* RSC; float wsc;
    bf16_t* Z; float wsv;
    __device__ __forceinline__ void operator()(const f32x4 (&acc)[2][2][4][2], const Unit& u, int wr, int wc, int fr, int fq) const {
        asm volatile("" : "+v"(fr), "+v"(fq));
        const int row0 = u.pm * BM + wr * 64 + fr; const int gc0 = u.pn * BM + wc * 32 + 8 * fq;
        if (u.pn >= 24) {
            const int vt = u.pn - 24, pnz = vt < 2 ? 4 + vt : vt < 4 ? 8 + vt : 14 + vt; const int col0 = pnz * BM + wc * 32 + 8 * fq;
#pragma unroll
            for (int ai = 0; ai < 2; ++ai)
#pragma unroll
                for (int m = 0; m < 4; ++m) { const float sc = ((const PG8_GAS float*)RSC)[row0 + ai * HALF + m * 16] * wsv;
                    PG8_GAS bf16_t* rowp = (PG8_GAS bf16_t*)Z + (size_t)(row0 + ai * HALF + m * 16) * E_ZQ + col0;
#pragma unroll
                    for (int bj = 0; bj < 2; ++bj) { const i32x4 a0 = __builtin_bit_cast(i32x4, acc[ai][bj][m][0]), a1 = __builtin_bit_cast(i32x4, acc[ai][bj][m][1]);
                        const f32x4 v0 = {(float)a0[0] * sc, (float)a0[1] * sc, (float)a0[2] * sc, (float)a0[3] * sc}, v1 = {(float)a1[0] * sc, (float)a1[1] * sc, (float)a1[2] * sc, (float)a1[3] * sc};
                        *(PG8_GAS u32x4*)(rowp + bj * HALF) = pack8(v0, v1); } }
            return; }
        f32x4 bv[2][2];
#pragma unroll
        for (int bj = 0; bj < 2; ++bj)
#pragma unroll
            for (int n = 0; n < 2; ++n) bv[bj][n] = *(const PG8_GAS f32x4*)((const PG8_GAS float*)bgate + gc0 + bj * HALF + 4 * n) * -1.4426950408889634f;
        float nl[2][4];
#pragma unroll
        for (int ai = 0; ai < 2; ++ai)
#pragma unroll
            for (int m = 0; m < 4; ++m) nl[ai][m] = ((const PG8_GAS float*)RSC)[row0 + ai * HALF + m * 16] * wsc;
        PG8_GAS char* gp = (PG8_GAS char*)Gt + ((size_t)(u.pm * 24 + u.pn) << 16) + (size_t)((wr * 4 + wc) * 1024) + (unsigned)((fq * 16 + fr) * 16);
#pragma unroll
        for (int ai = 0; ai < 2; ++ai)
#pragma unroll
            for (int m = 0; m < 4; ++m) { u32x4 w;
#pragma unroll
                for (int bj = 0; bj < 2; ++bj) { unsigned w0 = 0u, w1 = 0u; const i32x4 a0 = __builtin_bit_cast(i32x4, acc[ai][bj][m][0]), a1 = __builtin_bit_cast(i32x4, acc[ai][bj][m][1]);
#pragma unroll
                    for (int j = 0; j < 4; ++j) { w0 = __builtin_amdgcn_cvt_pk_u8_f32(sigm255n((float)a0[j], nl[ai][m], bv[bj][0][j]), j, w0); w1 = __builtin_amdgcn_cvt_pk_u8_f32(sigm255n((float)a1[j], nl[ai][m], bv[bj][1][j]), j, w1); }
                    w[2 * bj] = w0; w[2 * bj + 1] = w1; }
                __builtin_nontemporal_store(w, (PG8_GAS u32x4*)(gp + (ai * 4 + m) * 8192)); }
    }
};
__device__ __forceinline__ void unpack8(const u32x4 w, f32x4& a, f32x4& b) {
    a[0] = __uint_as_float(w.x << 16); a[1] = __uint_as_float(w.x & 0xffff0000u); a[2] = __uint_as_float(w.y << 16); a[3] = __uint_as_float(w.y & 0xffff0000u);
    b[0] = __uint_as_float(w.z << 16); b[1] = __uint_as_float(w.z & 0xffff0000u); b[2] = __uint_as_float(w.w << 16); b[3] = __uint_as_float(w.w & 0xffff0000u); }
struct EpiMergeCat {
    static constexpr bool PERM = true, AFTER_DRAIN = false, HOOK = true;
    const bf16_t* Gt; bf16_t* Out; int t1, t2;
    __device__ __forceinline__ bool at_hook(int t) const { return t == t1 || t == t2; }
    __device__ __forceinline__ void mid(f32x4 (&acc)[2][2][4][2], const Unit& u, int t, int wr, int wc, int fr, int fq) const {
        const int tnum = (t == t1) ? 0 : 8;
        const PG8_GAS char* gp = (const PG8_GAS char*)Gt + ((size_t)(u.pm * 24 + tnum + u.pn) << 16) + (size_t)((wr * 4 + wc) * 1024); const unsigned gL = (unsigned)((fq * 16 + fr) * 16);
#pragma unroll
        for (int ai = 0; ai < 2; ++ai) {
            u32x4 gn[4], gd[4];
#pragma unroll
            for (int m = 0; m < 4; ++m) { gn[m] = *(const PG8_GAS u32x4*)(gp + (ai * 4 + m) * 8192 + gL); gd[m] = *(const PG8_GAS u32x4*)(gp + (8 << 16) + (ai * 4 + m) * 8192 + gL); }
#pragma unroll
            for (int m = 0; m < 4; ++m)
#pragma unroll
                for (int bj = 0; bj < 2; ++bj)
#pragma unroll
                    for (int n = 0; n < 2; ++n)
#pragma unroll
                        for (int j = 0; j < 4; ++j) acc[ai][bj][m][n][j] *= ubyte(gn[m][2 * bj + n], j) * __builtin_amdgcn_rcpf(ubyte(gd[m][2 * bj + n], j));
            asm volatile("" ::: "memory"); }
    }
    __device__ __forceinline__ void operator()(const f32x4 (&acc)[2][2][4][2], const Unit& u, int wr, int wc, int fr, int fq) const {
        const size_t urow = (size_t)(u.pm * BM + wr * 64); const int ucol = u.pn * BM + wc * 32;
        const PG8_GAS char* gp = (const PG8_GAS char*)Gt + ((size_t)(u.pm * 24 + 16 + u.pn) << 16) + (size_t)((wr * 4 + wc) * 1024); const unsigned gL = (unsigned)((fq * 16 + fr) * 16);
        PG8_GAS char* oB = (PG8_GAS char*)Out + (urow * E_DM + ucol) * 2; const unsigned oL = (unsigned)(fr * E_DM + 8 * fq) * 2u;
#pragma unroll
        for (int ai = 0; ai < 2; ++ai) {
            u32x4 gw[4];
#pragma unroll
            for (int m = 0; m < 4; ++m) gw[m] = *(const PG8_GAS u32x4*)(gp + (ai * 4 + m) * 8192 + gL);
#pragma unroll
            for (int m = 0; m < 4; ++m)
#pragma unroll
                for (int bj = 0; bj < 2; ++bj) { f32x4 g0, g1;
#pragma unroll
                    for (int j = 0; j < 4; ++j) { g0[j] = ubyte(gw[m][2 * bj], j) * (1.0f / 255.0f); g1[j] = ubyte(gw[m][2 * bj + 1], j) * (1.0f / 255.0f); }
                    *(PG8_GAS u32x4*)(oB + (size_t)(ai * HALF + m * 16) * E_DM * 2 + bj * HALF * 2 + oL) = pack8(acc[ai][bj][m][0] * g0, acc[ai][bj][m][1] * g1); }
            asm volatile("" ::: "memory"); }
    }
};
template <bool FINAL, bool ROWSCALE, bool SUMSQ> struct EpiResid {
    static constexpr bool PERM = true, AFTER_DRAIN = false;
    bf16_t* XB; float* OUT; float* SSQ; PG8_LAS float* P;
    __device__ __forceinline__ void operator()(const f32x4 (&acc)[2][2][4][2], const Unit& u, int wr, int wc, int fr, int fq) const {
        const size_t urow = (size_t)(u.pm * BM + wr * 64); const int ucol = u.pn * BM + wc * 32;
        PG8_GAS char* xB = (PG8_GAS char*)XB + (urow * E_DM + ucol) * 2; const unsigned xL = (unsigned)(fr * E_DM + 8 * fq) * 2u;
        PG8_GAS char* oB = (PG8_GAS char*)OUT + (urow * E_DM + ucol) * 4; const unsigned oL = (unsigned)(fr * E_DM + 8 * fq) * 4u;
        const PG8_GAS char* sB = (const PG8_GAS char*)SSQ + urow * 32; const unsigned sL = (unsigned)fr * 32u;
#pragma unroll
        for (int ai = 0; ai < 2; ++ai) {
            u32x4 old[4][2]; f32x4 sq[4][2];
#pragma unroll
            for (int m = 0; m < 4; ++m) {
#pragma unroll
                for (int bj = 0; bj < 2; ++bj) old[m][bj] = *(const PG8_GAS u32x4*)(xB + (size_t)(ai * HALF + m * 16) * E_DM * 2 + bj * HALF * 2 + xL);
                if (ROWSCALE) { sq[m][0] = *(const PG8_GAS f32x4*)(sB + (size_t)(ai * HALF + m * 16) * 32 + sL); sq[m][1] = *(const PG8_GAS f32x4*)(sB + (size_t)(ai * HALF + m * 16) * 32 + 16 + sL); } }
#pragma unroll
            for (int m = 0; m < 4; ++m) {
                float sc = 1.f;
                if (ROWSCALE) { const f32x4 t = sq[m][0] + sq[m][1]; sc = __builtin_amdgcn_rcpf(((t[0] + t[1]) + (t[2] + t[3])) * (1.0f / E_DM) + 1e-6f); }
                float ss = 0.f;
#pragma unroll
                for (int bj = 0; bj < 2; ++bj) { f32x4 p0, p1; unpack8(old[m][bj], p0, p1);
                    const f32x4 v0 = p0 + acc[ai][bj][m][0] * sc, v1 = p1 + acc[ai][bj][m][1] * sc;
                    if (SUMSQ) ss += (v0[0] * v0[0] + v0[1] * v0[1]) + (v0[2] * v0[2] + v0[3] * v0[3]) + (v1[0] * v1[0] + v1[1] * v1[1]) + (v1[2] * v1[2] + v1[3] * v1[3]);
                    if (FINAL) { PG8_GAS char* op = oB + (size_t)(ai * HALF + m * 16) * E_DM * 4 + bj * HALF * 4 + oL; *(PG8_GAS f32x4*)op = v0; *(PG8_GAS f32x4*)(op + 16) = v1; }
                    else *(PG8_GAS u32x4*)(xB + (size_t)(ai * HALF + m * 16) * E_DM * 2 + bj * HALF * 2 + xL) = pack8(v0, v1); }
                if (SUMSQ) { ss += __int_as_float(__builtin_amdgcn_ds_swizzle(__float_as_int(ss), (16 << 10) | 0x1f));
                    auto rr = __builtin_amdgcn_permlane32_swap(__float_as_uint(ss), __float_as_uint(ss), false, false); ss = __uint_as_float(rr[0]) + __uint_as_float(rr[1]);
                    if (fq == 0) P[(ai * HALF + wr * 64 + m * 16 + fr) * 4 + wc] = ss; } }
            asm volatile("" ::: "memory"); }
        if (SUMSQ) {
            asm volatile("s_waitcnt lgkmcnt(0)" ::: "memory"); __builtin_amdgcn_s_barrier(); asm volatile("" ::: "memory");
            const int t = (wr * 4 + wc) * 64 + fq * 16 + fr;
            if (t < BM) { const f32x4 q = *(const PG8_LAS f32x4*)(P + t * 4); ((PG8_GAS float*)SSQ)[((size_t)u.pm * BM + t) * 8 + u.pn] = (q[0] + q[1]) + (q[2] + q[3]); }
        }
    }
};
struct EpiRelu2 {
    static constexpr bool PERM = true, AFTER_DRAIN = false;
    bf16_t* U; int ldc;
    __device__ __forceinline__ void operator()(const f32x4 (&acc)[2][2][4][2], const Unit& u, int wr, int wc, int fr, int fq) const {
        const int row0 = u.pm * BM + wr * 64 + fr, col0 = u.pn * BM + wc * 32 + 8 * fq;
#pragma unroll
        for (int ai = 0; ai < 2; ++ai)
#pragma unroll
            for (int m = 0; m < 4; ++m) { PG8_GAS bf16_t* rowp = (PG8_GAS bf16_t*)U + (size_t)(row0 + ai * HALF + m * 16) * ldc + col0;
#pragma unroll
                for (int bj = 0; bj < 2; ++bj) { f32x4 v0 = acc[ai][bj][m][0], v1 = acc[ai][bj][m][1];
#pragma unroll
                    for (int j = 0; j < 4; ++j) { const float a = fmaxf(v0[j], 0.f), b = fmaxf(v1[j], 0.f); v0[j] = a * a; v1[j] = b * b; }
                    __builtin_nontemporal_store(pack8(v0, v1), (PG8_GAS u32x4*)(rowp + bj * HALF)); } }
    }
};

template <class T, class = void> struct has_i8 { static constexpr bool value = false; };
template <class T> struct has_i8<T, decltype((void)T::I8)> { static constexpr bool value = true; };
template <bool I8> __device__ __forceinline__ f32x4 mma16(bf16x8 b, bf16x8 a, f32x4 c) {
    if constexpr (I8) return __builtin_bit_cast(f32x4, __builtin_amdgcn_mfma_i32_16x16x64_i8(__builtin_bit_cast(i32x4, b), __builtin_bit_cast(i32x4, a), __builtin_bit_cast(i32x4, c), 0, 0, 0));
    else return __builtin_amdgcn_mfma_f32_16x16x32_bf16(b, a, c, 0, 0, 0);
}
template <class T, class = void> struct has_hook { static constexpr bool value = false; };
template <class T> struct has_hook<T, decltype((void)T::HOOK)> { static constexpr bool value = true; };
template <class Epi, class Sched, bool ALIGN_EPI = false, bool SP2 = false>
__device__ __forceinline__ void gemm_phase(PG8_LAS unsigned char* lds, const Gemm g, const Sched& S, const Epi& E, const int tid) {
    const int wid = __builtin_amdgcn_readfirstlane(tid >> 6), lane = tid & 63, wr = wid >> 2, wc = wid & 3, fr = lane & 15, fq = lane >> 4;
    const int K = g.K, nt = K / BK, lda = g.lda;
    unsigned voffA[2], voffB[2];
#pragma unroll
    for (int i = 0; i < 2; ++i) { int R, C; stage_rc(tid * 16 + i * 8192, R, C); const int Rb = Epi::PERM ? ((R & ~31) + perm32(R & 31)) : R;
        voffA[i] = (unsigned)(R * lda + C) * 2u; voffB[i] = (unsigned)(Rb * K + C) * 2u; }
    const size_t kstep = (size_t)(BK * 2);
    const size_t hstepA = (size_t)HALF * lda * 2, hstepB = (size_t)HALF * K * 2;
    const size_t tstepA = 2 * hstepA, tstepB = 2 * hstepB;
    const unsigned ldsw = (unsigned)wid * 1024u;
    const int aoff = lds_byte(wr * 64 + fr, fq * 8), boff = lds_byte(wc * 32 + fr, fq * 8);
#define PG8_SA(b, h) (((b) * 2 + (h)) * HTB)
#define PG8_SB(b, h) ((4 + (b) * 2 + (h)) * HTB)
#define PG8_STAGE(bufoff, gbase, voff) do { _Pragma("unroll") for (int _i = 0; _i < 2; ++_i) \
        __builtin_amdgcn_global_load_lds((const unsigned*)((const char*)(gbase) + (voff)[_i]), (PG8_LAS unsigned*)(lds + (bufoff) + ldsw + _i * 8192), 16, 0, 0); } while (0)
#define PG8_LDA(dst, b, h) do { _Pragma("unroll") for (int m = 0; m < 4; ++m) _Pragma("unroll") for (int k = 0; k < 2; ++k) dst[m][k] = *(const PG8_LAS bf16x8*)(lds + PG8_SA(b, h) + aoff + m * 2048 + k * 1024); } while (0)
#define PG8_LDB(dst, b, h) do { _Pragma("unroll") for (int n = 0; n < 2; ++n) _Pragma("unroll") for (int k = 0; k < 2; ++k) dst[n][k] = *(const PG8_LAS bf16x8*)(lds + PG8_SB(b, h) + boff + n * 2048 + k * 1024); } while (0)
#define PG8_MMA(ai, bj, At, Bt) do { __builtin_amdgcn_s_setprio(1); _Pragma("unroll") for (int m = 0; m < 4; ++m) _Pragma("unroll") for (int n = 0; n < 2; ++n) _Pragma("unroll") for (int k = 0; k < 2; ++k) \
        acc[ai][bj][m][n] = mma16<has_i8<Epi>::value>(Bt[n][k], At[m][k], acc[ai][bj][m][n]); __builtin_amdgcn_s_setprio(0); } while (0)
#define PG8_WAIT_V(n) asm volatile("s_waitcnt vmcnt(" #n ")" ::: "memory")
#define PG8_WAIT_L(n) asm volatile("s_waitcnt lgkmcnt(" #n ")" ::: "memory")
#define PG8_BAR __builtin_amdgcn_s_barrier()
#define PG8_SCHED __builtin_amdgcn_sched_barrier(0)
    Unit cur, nxt; int ui = 0;
    if (!S.next(0, cur)) return;
    f32x4 acc[2][2][4][2];
#pragma unroll
    for (int a = 0; a < 2; ++a)
#pragma unroll
        for (int b = 0; b < 2; ++b)
#pragma unroll
            for (int m = 0; m < 4; ++m)
#pragma unroll
                for (int n = 0; n < 2; ++n) acc[a][b][m][n] = (f32x4){0.f, 0.f, 0.f, 0.f};
    bf16x8 At[4][2], B0[2][2], B1[2][2];
    const char* cA = (const char*)g.A + (size_t)cur.pm * tstepA; const char* cB = (const char*)g.Bt + (size_t)cur.pn * tstepB;
    S.a_ready(cur);
    if constexpr (SP2) {
        PG8_STAGE(PG8_SB(0, 0), cB, voffB); PG8_STAGE(PG8_SB(0, 1), cB + hstepB, voffB); PG8_STAGE(PG8_SA(0, 0), cA, voffA); PG8_STAGE(PG8_SA(0, 1), cA + hstepA, voffA);
        if (wr == 1) PG8_BAR;
        PG8_WAIT_V(2); PG8_BAR;
        PG8_STAGE(PG8_SB(1, 0), cB + kstep, voffB); PG8_STAGE(PG8_SA(1, 0), cA + kstep, voffA); PG8_STAGE(PG8_SB(1, 1), cB + hstepB + kstep, voffB);
        PG8_WAIT_V(6); PG8_BAR;
    } else {
        PG8_STAGE(PG8_SB(0, 0), cB, voffB); PG8_STAGE(PG8_SA(0, 0), cA, voffA); PG8_STAGE(PG8_SB(0, 1), cB + hstepB, voffB); PG8_STAGE(PG8_SA(0, 1), cA + hstepA, voffA);
        if (wr == 1) PG8_BAR;
        PG8_WAIT_V(4); PG8_BAR;
        PG8_STAGE(PG8_SB(1, 0), cB + kstep, voffB); PG8_STAGE(PG8_SA(1, 0), cA + kstep, voffA); PG8_STAGE(PG8_SB(1, 1), cB + hstepB + kstep, voffB);
        PG8_WAIT_V(6); PG8_BAR;
    }
    for (;;) {
        const bool has_next = S.next(ui + 1, nxt);
        const char* nA = has_next ? (const char*)g.A + (size_t)nxt.pm * tstepA : cA; const char* nB = has_next ? (const char*)g.Bt + (size_t)nxt.pn * tstepB : cB;
        for (int t = 0; t < nt; t += 2) {
            const bool last = (t == nt - 2);
            const char* a1 = cA + (size_t)(t + 1) * kstep;
            const char* a2 = last ? nA : cA + (size_t)(t + 2) * kstep; const char* b2 = last ? nB : cB + (size_t)(t + 2) * kstep;
            const char* a3 = a2 + kstep; const char* b3 = b2 + kstep;
            if (last && has_next) S.a_ready(nxt);
            if constexpr (has_hook<Epi>::value) { if (E.at_hook(t)) E.mid(acc, cur, t, wr, wc, fr, fq); }
            if constexpr (SP2) {
            PG8_LDB(B0, 0, 0); PG8_LDB(B1, 0, 1); PG8_SCHED; PG8_LDA(At, 0, 0); PG8_STAGE(PG8_SA(1, 1), a1 + hstepA, voffA);
            PG8_WAIT_V(8); PG8_WAIT_L(0); PG8_BAR; PG8_MMA(0, 0, At, B0); PG8_MMA(0, 1, At, B1); PG8_BAR; PG8_SCHED;
            PG8_LDA(At, 0, 1); PG8_STAGE(PG8_SB(0, 0), b2, voffB); PG8_STAGE(PG8_SB(0, 1), b2 + hstepB, voffB); PG8_STAGE(PG8_SA(0, 0), a2, voffA);
            PG8_WAIT_V(8); PG8_WAIT_L(0); PG8_BAR; PG8_MMA(1, 0, At, B0); PG8_MMA(1, 1, At, B1); PG8_BAR; PG8_SCHED;
            PG8_LDB(B0, 1, 0); PG8_LDB(B1, 1, 1); PG8_SCHED; PG8_LDA(At, 1, 0); PG8_STAGE(PG8_SA(0, 1), a2 + hstepA, voffA);
            PG8_WAIT_V(8); PG8_WAIT_L(0); PG8_BAR; PG8_MMA(0, 0, At, B0); PG8_MMA(0, 1, At, B1); PG8_BAR; PG8_SCHED;
            PG8_LDA(At, 1, 1); PG8_STAGE(PG8_SB(1, 0), b3, voffB); PG8_STAGE(PG8_SB(1, 1), b3 + hstepB, voffB); PG8_STAGE(PG8_SA(1, 0), a3, voffA);
            PG8_WAIT_V(8); PG8_WAIT_L(0); PG8_BAR; PG8_MMA(1, 0, At, B0); PG8_MMA(1, 1, At, B1); PG8_BAR; PG8_SCHED;
            } else {
            PG8_LDB(B0, 0, 0); PG8_SCHED; PG8_LDA(At, 0, 0); PG8_STAGE(PG8_SA(1, 1), a1 + hstepA, voffA);
            PG8_WAIT_L(8); PG8_BAR; PG8_WAIT_L(0); PG8_MMA(0, 0, At, B0); PG8_BAR; PG8_SCHED;
            PG8_LDB(B1, 0, 1); PG8_STAGE(PG8_SB(0, 0), b2, voffB);
            PG8_BAR; PG8_WAIT_L(0); PG8_MMA(0, 1, At, B1); PG8_BAR;
            PG8_LDA(At, 0, 1); PG8_STAGE(PG8_SA(0, 0), a2, voffA);
            PG8_BAR; PG8_WAIT_L(0); PG8_MMA(1, 0, At, B0); PG8_BAR; PG8_SCHED;
            PG8_STAGE(PG8_SB(0, 1), b2 + hstepB, voffB);
            PG8_WAIT_V(6); PG8_BAR; PG8_MMA(1, 1, At, B1); PG8_BAR;
            PG8_LDB(B0, 1, 0); PG8_SCHED; PG8_LDA(At, 1, 0); PG8_STAGE(PG8_SA(0, 1), a2 + hstepA, voffA);
            PG8_WAIT_L(8); PG8_BAR; PG8_WAIT_L(0); PG8_MMA(0, 0, At, B0); PG8_BAR; PG8_SCHED;
            PG8_LDB(B1, 1, 1); PG8_STAGE(PG8_SB(1, 0), b3, voffB);
            PG8_BAR; PG8_WAIT_L(0); PG8_MMA(0, 1, At, B1); PG8_BAR;
            PG8_LDA(At, 1, 1); PG8_STAGE(PG8_SA(1, 0), a3, voffA);
            PG8_BAR; PG8_WAIT_L(0); PG8_MMA(1, 0, At, B0); PG8_BAR; PG8_SCHED;
            PG8_STAGE(PG8_SB(1, 1), b3 + hstepB, voffB);
            PG8_WAIT_V(6); PG8_BAR; PG8_MMA(1, 1, At, B1); PG8_BAR;
            }
        }
        if constexpr (ALIGN_EPI) { if (wr == 0) PG8_BAR; }
        E(acc, cur, wr, wc, fr, fq); S.done(cur);
        if (!has_next) break;
#pragma unroll
        for (int a = 0; a < 2; ++a)
#pragma unroll
            for (int b = 0; b < 2; ++b)
#pragma unroll
                for (int m = 0; m < 4; ++m)
#pragma unroll
                    for (int n = 0; n < 2; ++n) acc[a][b][m][n] = (f32x4){0.f, 0.f, 0.f, 0.f};
        cur = nxt; cA = nA; cB = nB; ++ui;
        if constexpr (ALIGN_EPI) { if (wr == 1) PG8_BAR; }
    }
    PG8_WAIT_V(0);
    if constexpr (!ALIGN_EPI) { if (wr == 0) PG8_BAR; }
    PG8_BAR;
#undef PG8_SA
#undef PG8_SB
#undef PG8_STAGE
#undef PG8_LDA
#undef PG8_LDB
#undef PG8_MMA
#undef PG8_WAIT_V
#undef PG8_WAIT_L
#undef PG8_BAR
#undef PG8_SCHED
}
}
#define GAS __attribute__((address_space(1)))
#define LAS __attribute__((address_space(3)))
typedef unsigned short bf16;
typedef unsigned v4u __attribute__((ext_vector_type(4)));
typedef float f32x4 __attribute__((ext_vector_type(4)));
typedef short bf16x8 __attribute__((ext_vector_type(8)));
typedef GAS unsigned gu32;
typedef GAS unsigned long long gu64;
#define RLX_AGENT __ATOMIC_RELAXED, __HIP_MEMORY_SCOPE_AGENT
#define LDS_WAIT() asm volatile("s_waitcnt lgkmcnt(0)" ::: "memory")
#define VM_WAIT() asm volatile("s_waitcnt vmcnt(0)" ::: "memory")
__device__ __forceinline__ unsigned long long rt() { return __builtin_amdgcn_s_memrealtime(); }
__device__ __forceinline__ unsigned f2bf(float f) { unsigned u = __builtin_bit_cast(unsigned, f); return (u + 0x7fffu + ((u >> 16) & 1u)) >> 16; }
__device__ __forceinline__ unsigned pk2(float lo, float hi) { return pg8::cvt_pk_bf16(lo, hi); }

#define XB_TMO      128
#define XB_XCNT(j)  (256  + 64 * (j))
#define XB_XSUB(j)  (1280 + 64 * (j))
#define XB_XGEN(j)  (2304 + 64 * (j))
#define XB_TOP      3328
#define XB_TOPGEN   3392
#define XCD_BAR_WORDS 3456
#define XB_SPIN_CAP (1u << 18)

__device__ __forceinline__ unsigned xb_ld(unsigned* p)              { return __hip_atomic_load(p, __ATOMIC_RELAXED, __HIP_MEMORY_SCOPE_AGENT); }
__device__ __forceinline__ unsigned xb_add(unsigned* p, unsigned v) { return __hip_atomic_fetch_add(p, v, __ATOMIC_RELAXED, __HIP_MEMORY_SCOPE_AGENT); }
__device__ __forceinline__ unsigned xb_xcc_id() { return (unsigned)__builtin_amdgcn_s_getreg((3 << 11) | 20) & 0xFu; }
#define XB_SPIN(cond, bar) do { unsigned _sp = 0; while (cond) { __builtin_amdgcn_s_sleep(1); \
    if ((++_sp & 255u) == 0u) { if (xb_ld(&(bar)[XB_TMO])) break; if (_sp > XB_SPIN_CAP) { atomicAdd(&(bar)[XB_TMO], 1u); break; } } } } while (0)

struct XcdBarrier {
    unsigned* bar; unsigned x;
    volatile LAS unsigned* st;
};

__device__ __forceinline__ XcdBarrier xcd_barrier_post(unsigned* bar, volatile LAS unsigned* st) {
    XcdBarrier b; b.bar = bar; b.x = xb_xcc_id(); b.st = st;
    if (threadIdx.x == 0) (void)xb_add(&bar[XB_XCNT(b.x)], 1u);
    return b;
}
__device__ __forceinline__ void xcd_barrier_complete(unsigned* bar, unsigned x, unsigned& nloc, unsigned& nx) {
    const unsigned G = gridDim.x * gridDim.y * gridDim.z;
    unsigned sum, cnt, mine, sp = 0u;
    for (;;) {
        sum = 0u; cnt = 0u; mine = 0u;
#pragma unroll
        for (unsigned j = 0; j < 16; ++j) { const unsigned c = xb_ld(&bar[XB_XCNT(j)]); sum += c; cnt += (c > 0u) ? 1u : 0u; mine = (j == x) ? c : mine; }
        if (sum == G) break;
        __builtin_amdgcn_s_sleep(1);
        if ((++sp & 255u) == 0u) { if (xb_ld(&bar[XB_TMO])) break; if (sp > XB_SPIN_CAP) { atomicAdd(&bar[XB_TMO], 1u); break; } }
    }
    nloc = mine > 0u ? mine : 1u; nx = cnt > 0u ? cnt : 1u;
}

__device__ __forceinline__ void xcd_barrier(const XcdBarrier& b) {
    asm volatile("s_waitcnt vmcnt(0)" ::: "memory");
    __syncthreads();
    if (threadIdx.x == 0) {
        unsigned* bar = b.bar;
        __builtin_amdgcn_s_waitcnt(0);
        unsigned nloc = b.st[0], nx = b.st[1];
        if (nloc == 0u) { xcd_barrier_complete(bar, b.x, nloc, nx); b.st[0] = nloc; b.st[1] = nx; }
        const unsigned old = xb_add(&bar[XB_XSUB(b.x)], 1u);
        const unsigned gen = old / nloc;
        if (old + 1u == (gen + 1u) * nloc) {
            __builtin_amdgcn_fence(__ATOMIC_RELEASE, "agent");
            asm volatile("s_waitcnt vmcnt(0)" ::: "memory");
            const unsigned og = xb_add(&bar[XB_TOP], 1u);
            const unsigned tg = og / nx;
            if (og + 1u == (tg + 1u) * nx) xb_add(&bar[XB_TOPGEN], 1u);
            else XB_SPIN(xb_ld(&bar[XB_TOPGEN]) == tg, bar);
            __builtin_amdgcn_fence(__ATOMIC_ACQUIRE, "agent");
            xb_add(&bar[XB_XGEN(b.x)], 1u);
            asm volatile("s_waitcnt vmcnt(0)" ::: "memory");
        } else {
            XB_SPIN(xb_ld(&bar[XB_XGEN(b.x)]) == gen, bar);
            __builtin_amdgcn_fence(__ATOMIC_ACQUIRE, "agent");
            asm volatile("s_waitcnt vmcnt(0)" ::: "memory");
        }
    }
    __syncthreads();
}

constexpr int DM = 2048, BATCH = 16, SEQ = 2048, DEPTH = 4, MTOK = BATCH * SEQ;
constexpr int INC = 11524;
constexpr int ZQ = 5376;
constexpr int GWD = 6144;
constexpr int N1 = ZQ + GWD;
constexpr int DFF = 8192;
constexpr int FB_COL = 3072;
constexpr float EPS = 1e-6f;
static_assert(ZQ == pg8::E_ZQ && GWD == pg8::E_GW && DM == pg8::E_DM && DFF == pg8::E_DFF, "shape constants");
constexpr int NWAVES = 8;

constexpr size_t MiB = 1u << 20;
constexpr size_t WS_CTL = 0, CTL_ZERO_BYTES = 96 * 1024;
constexpr size_t WS_WIN = 2 * MiB;
constexpr size_t WS_WUA = 47 * MiB;
constexpr size_t WS_WUB = 49 * MiB;
constexpr size_t WS_WUC = 51 * MiB;
constexpr size_t WS_WOUT = 54 * MiB;
constexpr size_t WS_WFI = 62 * MiB;
constexpr size_t WS_WFO = 94 * MiB;
constexpr size_t WS_LOGF = 126 * MiB;
constexpr size_t WS_SSQ = 127 * MiB;
constexpr size_t WS_H = 128 * MiB;
constexpr size_t WS_OA = 256 * MiB;
constexpr size_t WS_OB = 288 * MiB;
constexpr size_t WS_OC = 320 * MiB;
constexpr size_t WS_ASCR = 368 * MiB;
constexpr size_t WS_Z = 400 * MiB;
constexpr size_t WS_G = 736 * MiB;
constexpr size_t WS_U = WS_Z;
constexpr size_t WS_XB = 1120 * MiB;
constexpr size_t WS_H8 = 928 * MiB;
constexpr size_t WS_W8 = 992 * MiB;
constexpr size_t WS_RSC = 126 * MiB + 512 * 1024;
constexpr int CW_WMAX = 21000;
constexpr size_t WS_END = 1248 * MiB;
static_assert(WS_U + (size_t)MTOK * DFF * 2 <= WS_END && WS_G + (size_t)MTOK * GWD * 2 <= WS_END && WS_Z + (size_t)MTOK * ZQ * 2 <= WS_G && WS_WFO + 32 * MiB <= WS_LOGF, "d_ws map");
constexpr int CW_BAR = 4096;
constexpr int CW_QUEUE = 16384;

constexpr int RING_OFF = 0, RING_BYTES = 131072;
constexpr int EPI_OFF = RING_BYTES, EPI_BYTES = 8192;
constexpr int MISC_OFF = EPI_OFF + EPI_BYTES;
constexpr int LDS_BYTES = 147456;
static_assert(MISC_OFF + 1024 + 6 * 128 * 4 <= LDS_BYTES, "LDS map");

constexpr int NPH = 9;

struct Args { const float* in[23]; float* out; unsigned char* ws; int gp_lo, gp_hi; };
#define KIN(i) (F.args->in[i])
struct Frame {
    const Args* args;
    LAS unsigned char* lds;
    volatile LAS unsigned* MISC;
    gu32* ctl;
    int tid, lane, wave, vcu, G, bx;
    float* out;
    unsigned char* ws;
};

template <int X> __device__ __forceinline__ float swz_xor(float v) { return __int_as_float(__builtin_amdgcn_ds_swizzle(__float_as_int(v), (X << 10) | 0x1f)); }
__device__ __forceinline__ float half_sum(float v) { v += swz_xor<1>(v); v += swz_xor<2>(v); v += swz_xor<4>(v); v += swz_xor<8>(v); v += swz_xor<16>(v); return v; }
__device__ __forceinline__ float wave_sum(float v) {
    v = half_sum(v);
    auto rr = __builtin_amdgcn_permlane32_swap(__float_as_uint(v), __float_as_uint(v), false, false);
    return __uint_as_float(rr[0]) + __uint_as_float(rr[1]);
}
__device__ __forceinline__ float wave_max(float v) {
    v = fmaxf(v, swz_xor<1>(v)); v = fmaxf(v, swz_xor<2>(v)); v = fmaxf(v, swz_xor<4>(v)); v = fmaxf(v, swz_xor<8>(v)); v = fmaxf(v, swz_xor<16>(v));
    auto rr = __builtin_amdgcn_permlane32_swap(__float_as_uint(v), __float_as_uint(v), false, false);
    return fmaxf(__uint_as_float(rr[0]), __uint_as_float(rr[1]));
}
__device__ __forceinline__ float shfl_lane(float v, int srclane) { return __int_as_float(__builtin_amdgcn_ds_bpermute(srclane << 2, __float_as_int(v))); }
__device__ __forceinline__ float bflo(unsigned w) { return __uint_as_float(w << 16); }
__device__ __forceinline__ float bfhi(unsigned w) { return __uint_as_float(w & 0xffff0000u); }

__device__ __forceinline__ void transpose_item(const float* W, int ldw, int K  , bf16* WT, int n0s, int n0d, int k0, int kofs, LAS float* scr, int lane, const float* kgain) {
#pragma unroll 8
    for (int i = 0; i < 32; ++i) { const int kk = 2 * i + (lane >> 5); scr[kk * 33 + (lane & 31)] = ((const GAS float*)W)[(size_t)(k0 + kk) * ldw + n0s + (lane & 31)] * (kgain ? ((const GAS float*)kgain)[k0 + kk] : 1.0f); }
    LDS_WAIT(); asm volatile("" ::: "memory");
    const int c = lane & 7;
#pragma unroll
    for (int j = 0; j < 4; ++j) { const int n = (lane >> 3) + 8 * j; const LAS float* s = scr + (8 * c) * 33 + n;
        v4u o; o.x = pk2(s[0 * 33], s[1 * 33]); o.y = pk2(s[2 * 33], s[3 * 33]); o.z = pk2(s[4 * 33], s[5 * 33]); o.w = pk2(s[6 * 33], s[7 * 33]);
        *(GAS v4u*)((GAS bf16*)WT + (size_t)(n0d + n) * K + kofs + k0 + 8 * c) = o; }
    LDS_WAIT(); asm volatile("" ::: "memory");
}
typedef unsigned u32x2 __attribute__((ext_vector_type(2)));
__device__ __forceinline__ unsigned q8b(float v) { return (unsigned)((int)__builtin_rintf(v)) & 0xffu; }
__device__ __forceinline__ void transpose_item_i8(const float* W, int ldw, unsigned char* WT, int n0s, int n0d, int k0, LAS float* scr, int lane, float qs) {
#pragma unroll 8
    for (int i = 0; i < 32; ++i) { const int kk = 2 * i + (lane >> 5); scr[kk * 33 + (lane & 31)] = ((const GAS float*)W)[(size_t)(k0 + kk) * ldw + n0s + (lane & 31)] * qs; }
    LDS_WAIT(); asm volatile("" ::: "memory");
    const int c = lane & 7;
#pragma unroll
    for (int j = 0; j < 4; ++j) { const int n = (lane >> 3) + 8 * j; const LAS float* s = scr + (8 * c) * 33 + n;
        u32x2 o; o.x = q8b(s[0 * 33]) | (q8b(s[1 * 33]) << 8) | (q8b(s[2 * 33]) << 16) | (q8b(s[3 * 33]) << 24); o.y = q8b(s[4 * 33]) | (q8b(s[5 * 33]) << 8) | (q8b(s[6 * 33]) << 16) | (q8b(s[7 * 33]) << 24);
        *(GAS u32x2*)((GAS unsigned char*)WT + (size_t)(n0d + n) * DM + k0 + 8 * c) = o; }
    LDS_WAIT(); asm volatile("" ::: "memory");
}
__device__ __forceinline__ bool transpose_pick(int& r, const float* W, int ldw, int K, int Ndst, int skip_at, int skip, bf16* WT, LAS float* scr, int lane, int pitch = 0, int kofs = 0, const float* kgain = nullptr) {
    const int nblk = Ndst / 32, items = (K / 64) * nblk;
    if (r >= items) { r -= items; return false; }
    const int kb = r / nblk, nb = r % nblk, n0d = 32 * nb, n0s = n0d + (n0d >= skip_at ? skip : 0);
    transpose_item(W, ldw, pitch ? pitch : K, WT, n0s, n0d, 64 * kb, kofs, scr, lane, kgain);
    return true;
}
constexpr int W_NITEMS = (DM / 64) * (N1 / 32) + 2 * (512 / 64) * (DM / 32) + (768 / 64) * (DM / 32) + (DM / 64) * (DM / 32) + (DM / 64) * (DFF / 32) + (DFF / 64) * (DM / 32);
__device__ __forceinline__ void weights_item(Frame& F, int layer, int it, LAS float* scr, const float qs8w  ) {
    unsigned char* wb = F.ws;
    int r = it;
    { constexpr int nblk = (14 * 256) / 32, items = (DM / 64) * nblk;
      if (r < items) { const int kb = r / nblk, nb = r % nblk, c0 = 32 * nb, t = c0 >> 8, pn = t < 4 ? t : t < 8 ? t + 2 : t + 4, z0 = pn * 256 + (c0 & 255);
          transpose_item(KIN(2) + (size_t)layer * DM * INC, INC, DM, (bf16*)(wb + WS_WIN), z0 + (z0 >= FB_COL ? 4 : 0), c0, 64 * kb, 0, scr, F.lane, nullptr); return; }
      r -= items; }
    { constexpr int nblk = (7 * 256) / 32, items = (DM / 64) * nblk;
      if (r < items) { const int kb = r / nblk, nb = r % nblk, j0 = 32 * nb, z0 = j0 < 512 ? 1024 + j0 : j0 < 1024 ? 2560 + (j0 - 512) : 4608 + (j0 - 1024);
          transpose_item_i8(KIN(2) + (size_t)layer * DM * INC, INC, (unsigned char*)(wb + WS_W8), z0 + (z0 >= FB_COL ? 4 : 0), GWD + j0, 64 * kb, scr, F.lane, qs8w); return; }
      r -= items; }
    { constexpr int nblk = GWD / 32, items = (DM / 64) * nblk;
      if (r < items) { const int kb = r / nblk, nb = r % nblk;
          transpose_item_i8(KIN(2) + (size_t)layer * DM * INC, INC, (unsigned char*)(wb + WS_W8), ZQ + 4 + 32 * nb, 32 * nb, 64 * kb, scr, F.lane, qs8w); return; }
      r -= items; }
    if (transpose_pick(r, KIN(16) + (size_t)layer * 512 * DM, DM, 512, DM, 1 << 30, 0, (bf16*)(wb + WS_WUA), scr, F.lane, 1792, 0)) return;
    if (transpose_pick(r, KIN(17) + (size_t)layer * 512 * DM, DM, 512, DM, 1 << 30, 0, (bf16*)(wb + WS_WUA), scr, F.lane, 1792, 512)) return;
    if (transpose_pick(r, KIN(18) + (size_t)layer * 768 * DM, DM, 768, DM, 1 << 30, 0, (bf16*)(wb + WS_WUA), scr, F.lane, 1792, 1024)) return;
    if (transpose_pick(r, KIN(19) + (size_t)layer * DM * DM, DM, DM, DM, 1 << 30, 0, (bf16*)(wb + WS_WOUT), scr, F.lane)) return;
    if (transpose_pick(r, KIN(21) + (size_t)layer * DM * DFF, DFF, DM, DFF, 1 << 30, 0, (bf16*)(wb + WS_WFI), scr, F.lane, 0, 0, KIN(20) + (size_t)layer * DM)) return;
    transpose_pick(r, KIN(22) + (size_t)layer * DFF * DM, DM, DFF, DM, 1 << 30, 0, (bf16*)(wb + WS_WFO), scr, F.lane);
}
__device__ __forceinline__ void p_weights(Frame& F, int layer) {
    LAS float* scr = (LAS float*)(F.lds + RING_OFF + F.wave * 8448);
    const int gw = F.vcu * NWAVES + F.wave, NGW = F.G * NWAVES;
    const float qs8w = 127.0f / fmaxf(__uint_as_float(__hip_atomic_load(F.ctl + CW_WMAX + layer, __ATOMIC_RELAXED, __HIP_MEMORY_SCOPE_AGENT)), 1e-30f);
    for (int it = gw; it < W_NITEMS; it += NGW) weights_item(F, layer, it, scr, qs8w);
}
__device__ __forceinline__ void p_weights_dyn(Frame& F, int layer, gu32* ctr) {
    LAS float* scr = (LAS float*)(F.lds + RING_OFF + F.wave * 8448);
    constexpr int CH = 4;
    for (;;) {
        int base = 0; if (F.lane == 0) base = (int)__hip_atomic_fetch_add(ctr, (unsigned)CH, RLX_AGENT);
        base = __builtin_amdgcn_readfirstlane(base);
        if (base >= W_NITEMS) break;
        for (int j = 0; j < CH; ++j) if (base + j < W_NITEMS) weights_item(F, layer, base + j, scr, 0.f);
    }
}
__device__ __forceinline__ void wmax_scan(Frame& F, int layer, int rank, int nw) {
    const GAS float* wg = (const GAS float*)(KIN(2) + (size_t)layer * DM * INC); float mx = 0.f; constexpr int WCH = (INC + 63) / 64;
    const int r0 = __builtin_amdgcn_readfirstlane(rank); int ln = F.lane; asm volatile("" : "+v"(ln));
    for (int c = r0; c < DM * WCH; c += 16 * nw) {
        float t[16];
#pragma unroll
        for (int u = 0; u < 16; ++u) { const int cu = c + u * nw; const int cv = cu < DM * WCH ? cu : r0; const int kk = cv / WCH, cc = cv % WCH; const int col = 64 * cc + ln; t[u] = wg[(size_t)kk * INC + (col < INC ? col : 0)]; }
#pragma unroll
        for (int u = 0; u < 16; ++u) mx = fmaxf(mx, fabsf(t[u])); }
    mx = wave_max(mx);
    if (F.lane == 0) __hip_atomic_fetch_max(F.ctl + CW_WMAX + layer, __float_as_uint(mx), __ATOMIC_RELAXED, __HIP_MEMORY_SCOPE_AGENT);
}
template <bool FB, bool IN_F32>
__device__ __forceinline__ void p_norm(Frame& F, const float* X, const float* g, bf16* H, bf16* XB, const float* bfg, float* logf, const LAS float* wfb) {
    const int gw = F.vcu * NWAVES + F.wave, NGW = F.G * NWAVES, lane = F.lane;
    const GAS float* Xg = (const GAS float*)X; GAS bf16* xb = (GAS bf16*)XB; GAS bf16* Hg = (GAS bf16*)H; GAS float* logfg = (GAS float*)logf;
    f32x4 gv[4][2];
#pragma unroll
    for (int j = 0; j < 4; ++j) { gv[j][0] = *(const GAS f32x4*)((const GAS float*)g + 8 * lane + 512 * j); gv[j][1] = *(const GAS f32x4*)((const GAS float*)g + 8 * lane + 512 * j + 4); }
    for (int m = gw; m < MTOK; m += NGW) {
        f32x4 v[4][2]; float s = 0.f;
        if (IN_F32) {
#pragma unroll
            for (int j = 0; j < 4; ++j) { v[j][0] = *(const GAS f32x4*)(Xg + (size_t)m * DM + 8 * lane + 512 * j); v[j][1] = *(const GAS f32x4*)(Xg + (size_t)m * DM + 8 * lane + 512 * j + 4); }
#pragma unroll
            for (int j = 0; j < 4; ++j) { v4u o; o.x = pk2(v[j][0][0], v[j][0][1]); o.y = pk2(v[j][0][2], v[j][0][3]); o.z = pk2(v[j][1][0], v[j][1][1]); o.w = pk2(v[j][1][2], v[j][1][3]);
                *(GAS v4u*)(xb + (size_t)m * DM + 8 * lane + 512 * j) = o;
                v[j][0] = (f32x4){bflo(o.x), bfhi(o.x), bflo(o.y), bfhi(o.y)}; v[j][1] = (f32x4){bflo(o.z), bfhi(o.z), bflo(o.w), bfhi(o.w)}; }
        } else {
#pragma unroll
            for (int j = 0; j < 4; ++j) { const v4u w = *(const GAS v4u*)(xb + (size_t)m * DM + 8 * lane + 512 * j);
                v[j][0] = (f32x4){bflo(w.x), bfhi(w.x), bflo(w.y), bfhi(w.y)}; v[j][1] = (f32x4){bflo(w.z), bfhi(w.z), bflo(w.w), bfhi(w.w)}; }
        }
#pragma unroll
        for (int j = 0; j < 4; ++j)
#pragma unroll
            for (int q = 0; q < 2; ++q) s += (v[j][q][0] * v[j][q][0] + v[j][q][1] * v[j][q][1]) + (v[j][q][2] * v[j][q][2] + v[j][q][3] * v[j][q][3]);
        const float rstd = 1.0f / sqrtf(wave_sum(s) * (1.0f / DM) + EPS);
        float mraw = 0.f;
#pragma unroll
        for (int j = 0; j < 4; ++j)
#pragma unroll
            for (int q = 0; q < 2; ++q)
#pragma unroll
                for (int e = 0; e < 4; ++e) mraw = fmaxf(mraw, fabsf(v[j][q][e] * gv[j][q][e]));
        const float hmax = fmaxf(wave_max(mraw) * rstd, 1e-30f), qs8 = 127.0f / hmax;
        if (lane == 0) ((GAS float*)(F.ws + WS_RSC))[m] = hmax * (1.0f / 127.0f);
        float f0 = 0.f, f1 = 0.f, f2 = 0.f, f3 = 0.f;
#pragma unroll
        for (int j = 0; j < 4; ++j) { v[j][0] = v[j][0] * rstd * gv[j][0]; v[j][1] = v[j][1] * rstd * gv[j][1];
            if (FB) {
#pragma unroll
                for (int e = 0; e < 8; ++e) { const f32x4 w = *(const LAS f32x4*)(wfb + (size_t)(8 * lane + 512 * j + e) * 4); const float hv = v[j][e >> 2][e & 3]; f0 += hv * w[0]; f1 += hv * w[1]; f2 += hv * w[2]; f3 += hv * w[3]; }
            }
            v4u o; o.x = pk2(v[j][0][0], v[j][0][1]); o.y = pk2(v[j][0][2], v[j][0][3]); o.z = pk2(v[j][1][0], v[j][1][1]); o.w = pk2(v[j][1][2], v[j][1][3]);
            *(GAS v4u*)(Hg + (size_t)m * DM + 8 * lane + 512 * j) = o;
            { u32x2 q; q.x = q8b(v[j][0][0] * qs8) | (q8b(v[j][0][1] * qs8) << 8) | (q8b(v[j][0][2] * qs8) << 16) | (q8b(v[j][0][3] * qs8) << 24);
              q.y = q8b(v[j][1][0] * qs8) | (q8b(v[j][1][1] * qs8) << 8) | (q8b(v[j][1][2] * qs8) << 16) | (q8b(v[j][1][3] * qs8) << 24);
              *(GAS u32x2*)((GAS unsigned char*)(F.ws + WS_H8) + (size_t)m * DM + 8 * lane + 512 * j) = q; }
            if (FB) asm volatile("" ::: "memory"); }
        if (FB) {
            f0 = wave_sum(f0); f1 = wave_sum(f1); f2 = wave_sum(f2); f3 = wave_sum(f3);
            if (lane < 4) { float z = (lane == 0 ? f0 : lane == 1 ? f1 : lane == 2 ? f2 : f3) + ((const GAS float*)bfg)[lane];
                const float ls = fminf(z, 0.f) - log1pf(expf(-fabsf(z)));
                logfg[(size_t)m * 4 + lane] = ls; }
        }
    }
}
namespace att {
typedef short bf16x8 __attribute__((ext_vector_type(8)));
typedef short s16x4 __attribute__((ext_vector_type(4)));
typedef float f32x16 __attribute__((ext_vector_type(16)));
typedef float f32x4 __attribute__((ext_vector_type(4)));
typedef unsigned u32x4 __attribute__((ext_vector_type(4)));
constexpr int KVBLK = 64, QB = 256;
constexpr int SHM_V = KVBLK * 128 * 2, SHM_K = KVBLK * 128 * 2;
constexpr int L_V = 0, L_K = 2 * SHM_V, L_WS = 2 * SHM_V + 2 * SHM_K, L_TBL = L_WS + 8 * 256;
constexpr int TBL_N = 2176;
constexpr int ATT_LDS = L_TBL + TBL_N * 4;
#define KSWZ(row, colB) ((row) * 256 + ((colB) ^ (((row) & 15) << 4)))
#define SBAR() __builtin_amdgcn_sched_barrier(0)
__device__ __forceinline__ int v_st(int k, int c) { const int kk = (k & ~0xC) | ((k & 4) << 1) | ((k & 8) >> 1); return ((kk >> 3) * 4 + (c >> 5)) * 512 + ((kk & 7) * 32 + (c & 31)) * 2; }
__device__ __forceinline__ int v_rd_base(int lane) { return ((lane & 3) << 3) | (((lane >> 2) & 3) << 6) | (((lane >> 4) & 1) << 5) | (((lane >> 5) & 1) << 8); }
constexpr int v_rd_off(int d0, int ks, int half) { return d0 * 512 + ks * 4096 + half * 2048; }
__device__ __forceinline__ int crow(int r, int hi) { return (r & 3) + 8 * (r >> 2) + 4 * hi; }
__device__ __forceinline__ unsigned cvtpk(float lo, float hi) { return pg8::cvt_pk_bf16(lo, hi); }

template <int KB, int NQ>
__device__ __forceinline__ void qkt(f32x16& p0, f32x16& p1, const LAS char* K_lds, int r32, int hi, const bf16x8* qr) {
    const LAS char* kb[NQ];
#pragma unroll
    for (int dd = 0; dd < NQ; ++dd) kb[dd] = K_lds + KB * SHM_K + KSWZ(r32, (dd * 16 + hi * 8) * 2);
#pragma unroll
    for (int d0 = 0; d0 < NQ; ++d0) { const LAS char* a = kb[d0];
        bf16x8 b0 = *(const LAS bf16x8*)(a);
        bf16x8 b1 = *(const LAS bf16x8*)(a + 32 * 256);
        p0 = __builtin_amdgcn_mfma_f32_32x32x16_bf16(b0, qr[d0], p0, 0, 0, 0);
        p1 = __builtin_amdgcn_mfma_f32_32x32x16_bf16(b1, qr[d0], p1, 0, 0, 0); }
}
template <int VB>
__device__ __forceinline__ void pv_tile(f32x16* o, int vb0, bf16x8 pa0, bf16x8 pa1, bf16x8 pa2, bf16x8 pa3) {
    s16x4 xl0, xl1, xl2, xl3, xh0, xh1, xh2, xh3, yl0, yl1, yl2, yl3, yh0, yh1, yh2, yh3;
#define TRRD(dst, off) asm volatile("ds_read_b64_tr_b16 %0, %1 offset:%2" : "=&v"(dst) : "v"(vb0), "i"(off) : "memory")
#define PV_RD(d0, S) do { constexpr int b_ = VB * SHM_V + v_rd_off(d0, 0, 0); \
        TRRD(S##l0, b_); TRRD(S##h0, b_ + 2048); TRRD(S##l1, b_ + 4096); TRRD(S##h1, b_ + 6144); TRRD(S##l2, b_ + 8192); TRRD(S##h2, b_ + 10240); TRRD(S##l3, b_ + 12288); TRRD(S##h3, b_ + 14336); } while (0)
#define PV_MM(d0, S) do { \
        o[d0] = __builtin_amdgcn_mfma_f32_32x32x16_bf16((bf16x8){S##l0[0], S##l0[1], S##l0[2], S##l0[3], S##h0[0], S##h0[1], S##h0[2], S##h0[3]}, pa0, o[d0], 0, 0, 0); \
        o[d0] = __builtin_amdgcn_mfma_f32_32x32x16_bf16((bf16x8){S##l1[0], S##l1[1], S##l1[2], S##l1[3], S##h1[0], S##h1[1], S##h1[2], S##h1[3]}, pa1, o[d0], 0, 0, 0); \
        o[d0] = __builtin_amdgcn_mfma_f32_32x32x16_bf16((bf16x8){S##l2[0], S##l2[1], S##l2[2], S##l2[3], S##h2[0], S##h2[1], S##h2[2], S##h2[3]}, pa2, o[d0], 0, 0, 0); \
        o[d0] = __builtin_amdgcn_mfma_f32_32x32x16_bf16((bf16x8){S##l3[0], S##l3[1], S##l3[2], S##l3[3], S##h3[0], S##h3[1], S##h3[2], S##h3[3]}, pa3, o[d0], 0, 0, 0); SBAR(); } while (0)
#define PV_WAIT(n) do { asm volatile("s_waitcnt lgkmcnt(" #n ")" ::: "memory"); SBAR(); } while (0)
    PV_RD(0, x); PV_RD(1, y);
    PV_WAIT(8); PV_MM(0, x); PV_RD(2, x);
    PV_WAIT(8); PV_MM(1, y); PV_RD(3, y);
    PV_WAIT(8); PV_MM(2, x);
    PV_WAIT(0); PV_MM(3, y);
#undef PV_WAIT
#undef PV_MM
#undef PV_RD
#undef TRRD
}
__device__ __forceinline__ void softmax_tile(f32x16& p0, f32x16& p1, float& m_reg, float& l_reg, float& alpha, bf16x8& pa0, bf16x8& pa1, bf16x8& pa2, bf16x8& pa3) {
    float pmax = p0[0];
#pragma unroll
    for (int r = 1; r < 16; ++r) pmax = fmaxf(pmax, p0[r]);
#pragma unroll
    for (int r = 0; r < 16; ++r) pmax = fmaxf(pmax, p1[r]);
    { auto rr = __builtin_amdgcn_permlane32_swap(__float_as_uint(pmax), __float_as_uint(pmax), false, false);
      pmax = fmaxf(__uint_as_float(rr[0]), __uint_as_float(rr[1])); }
    const float mn = fmaxf(m_reg, pmax);
    alpha = __builtin_amdgcn_exp2f(m_reg - mn); m_reg = mn;
    float ps = 0.f;
#pragma unroll
    for (int r = 0; r < 16; ++r) { p0[r] = __builtin_amdgcn_exp2f(p0[r] - mn); ps += p0[r]; }
#pragma unroll
    for (int r = 0; r < 16; ++r) { p1[r] = __builtin_amdgcn_exp2f(p1[r] - mn); ps += p1[r]; }
    { auto rr = __builtin_amdgcn_permlane32_swap(__float_as_uint(ps), __float_as_uint(ps), false, false);
      ps = __uint_as_float(rr[0]) + __uint_as_float(rr[1]); }
    l_reg = l_reg * alpha + ps;
#define PK4(P, B_, OUT) do { unsigned a0 = cvtpk(P[B_+0], P[B_+1]), a1 = cvtpk(P[B_+2], P[B_+3]); \
        unsigned b0 = cvtpk(P[B_+4], P[B_+5]), b1 = cvtpk(P[B_+6], P[B_+7]); \
        auto r0 = __builtin_amdgcn_permlane32_swap(a0, b0, false, false); auto r1 = __builtin_amdgcn_permlane32_swap(a1, b1, false, false); \
        u32x4 w = {r0[0], r1[0], r0[1], r1[1]}; OUT = *reinterpret_cast<bf16x8*>(&w); } while (0)
    PK4(p0, 0, pa0); PK4(p0, 8, pa1); PK4(p1, 0, pa2); PK4(p1, 8, pa3);
#undef PK4
}

__device__ __forceinline__ void softmax_nomax(f32x16& p0, f32x16& p1, float& l_reg, bf16x8& pa0, bf16x8& pa1, bf16x8& pa2, bf16x8& pa3) {
    float ps = 0.f;
#pragma unroll
    for (int r = 0; r < 16; ++r) { p0[r] = __builtin_amdgcn_exp2f(p0[r]); ps += p0[r]; }
#pragma unroll
    for (int r = 0; r < 16; ++r) { p1[r] = __builtin_amdgcn_exp2f(p1[r]); ps += p1[r]; }
    { auto rr = __builtin_amdgcn_permlane32_swap(__float_as_uint(ps), __float_as_uint(ps), false, false);
      ps = __uint_as_float(rr[0]) + __uint_as_float(rr[1]); }
    l_reg += ps;
#define PK4(P, B_, OUT) do { unsigned a0 = cvtpk(P[B_+0], P[B_+1]), a1 = cvtpk(P[B_+2], P[B_+3]); \
        unsigned b0 = cvtpk(P[B_+4], P[B_+5]), b1 = cvtpk(P[B_+6], P[B_+7]); \
        auto r0 = __builtin_amdgcn_permlane32_swap(a0, b0, false, false); auto r1 = __builtin_amdgcn_permlane32_swap(a1, b1, false, false); \
        u32x4 w = {r0[0], r1[0], r0[1], r1[1]}; OUT = *reinterpret_cast<bf16x8*>(&w); } while (0)
    PK4(p0, 0, pa0); PK4(p0, 8, pa1); PK4(p1, 0, pa2); PK4(p1, 8, pa3);
#undef PK4
}

enum { KIND_A = 0, KIND_B = 1, KIND_C = 2 };
struct UnitDesc { int kind, h, b, qb; };
constexpr int NUNITS = 8 * BATCH * 14;
__device__ __forceinline__ UnitDesc decode_unit(int u) {
    UnitDesc d; d.qb = 7 - u / (BATCH * 14); const int r = u % (BATCH * 14); const int hk = r / BATCH; d.b = r % BATCH;
    if (hk < 4) { d.kind = KIND_A; d.h = hk; } else if (hk < 10) { d.kind = KIND_C; d.h = hk - 4; } else { d.kind = KIND_B; d.h = hk - 10; }
    return d;
}

struct NoTable { __device__ __forceinline__ void operator()() const {} };
template <int KIND, int DQK, class TB>
__device__ __forceinline__ void attn_pass(const GAS bf16* Qp, const GAS bf16* Kp, const GAS bf16* Vp, int Q0, LAS char* lds, int tid, f32x16 (&o)[4], float& l_out, const float C2, const TB& build_table, const float slope2 = 0.f  ) {
    constexpr int NQ = DQK / 16;
    const int wid = __builtin_amdgcn_readfirstlane(tid >> 6), lane = tid & 63, r32 = lane & 31, hi = lane >> 5;
    LAS char* V_lds = lds + L_V; LAS char* K_lds = lds + L_K;
    const LAS float* tbl = (const LAS float*)(lds + L_TBL);
    const int qlo = Q0 + wid * 32, qpos = qlo + r32;
    bf16x8 qr[NQ];
#pragma unroll
    for (int d0 = 0; d0 < NQ; ++d0) qr[d0] = *(const GAS bf16x8*)(Qp + (size_t)qpos * ZQ + d0 * 16 + hi * 8);
    const int sr = tid >> 4, sc = (tid & 15) * 8;
    const int vst0 = v_st(sr, sc), vst1 = v_st(32 + sr, sc);
    const int kws = KSWZ(sr, sc * 2);
    const int kr64 = tid >> 3, kc64 = (tid & 7) * 8, kws64 = KSWZ(kr64, kc64 * 2);
    const int vb0 = (int)(unsigned)(uintptr_t)V_lds + v_rd_base(lane);
    bf16x8 st_v0, st_v1, st_k0, st_k1;
#define SLOAD(k0) do { st_v0 = *(const GAS bf16x8*)(Vp + (size_t)((k0) + sr) * ZQ + sc); st_v1 = *(const GAS bf16x8*)(Vp + (size_t)((k0) + 32 + sr) * ZQ + sc); \
        if (DQK == 128) { st_k0 = *(const GAS bf16x8*)(Kp + (size_t)((k0) + sr) * ZQ + sc); st_k1 = *(const GAS bf16x8*)(Kp + (size_t)((k0) + 32 + sr) * ZQ + sc); } \
        else { st_k0 = *(const GAS bf16x8*)(Kp + (size_t)((k0) + kr64) * ZQ + kc64); } } while (0)
#define SWRITE(bf) do { *(LAS bf16x8*)(V_lds + (bf) * SHM_V + vst0) = st_v0; *(LAS bf16x8*)(V_lds + (bf) * SHM_V + vst1) = st_v1; \
        if (DQK == 128) { *(LAS bf16x8*)(K_lds + (bf) * SHM_K + kws) = st_k0; *(LAS bf16x8*)(K_lds + (bf) * SHM_K + kws + 32 * 256) = st_k1; } \
        else { *(LAS bf16x8*)(K_lds + (bf) * SHM_K + kws64) = st_k0; } } while (0)
    float l_reg = 0.f;
#pragma unroll
    for (int d = 0; d < 4; ++d) o[d] = f32x16{};
    const int tmax = Q0 / KVBLK + 3;
    SLOAD(tmax * KVBLK); build_table(); asm volatile("s_waitcnt vmcnt(0)" ::: "memory"); SWRITE(0);
    __syncthreads();
    float cq = 0.f; if (KIND == KIND_B) cq = -tbl[qpos];
    int tl = 0;
    if (KIND == KIND_B) {
        const bool need = (lane > tmax) || (tbl[64 * (lane < 32 ? lane : 0) + 63] - tbl[Q0] >= -172.0f) || lane >= 32;
        const unsigned long long mk = __ballot(need);
        tl = (__ffsll((long long)mk) - 1) & ~1;
    } else {
        const int kmin = Q0 - (int)(174.0f / slope2);
        tl = kmin > 0 ? ((kmin >> 6) & ~1) : 0;
    }
    tl = __builtin_amdgcn_readfirstlane(tl);
#define TILE_STEP(BUF, t_) do { const int kb_ = (t_) * KVBLK; \
        if ((t_) > tl) SLOAD(kb_ - KVBLK); \
        if (kb_ <= qlo + 31) {                                    \
            f32x16 p0, p1; bf16x8 pa0, pa1, pa2, pa3; \
            if (KIND == KIND_B) {                                 \
                const LAS f32x4* tb = (const LAS f32x4*)(tbl + kb_ + 4 * hi); \
                _Pragma("unroll") for (int g = 0; g < 4; ++g) { const f32x4 b0 = tb[2 * g], b1 = tb[2 * g + 8]; \
                    _Pragma("unroll") for (int j = 0; j < 4; ++j) { p0[4 * g + j] = b0[j] + cq; p1[4 * g + j] = b1[j] + cq; } }     \
            } else {                                              \
                const LAS float* tb = tbl + (2047 - (qpos - kb_ - 4 * hi)); \
                _Pragma("unroll") for (int r = 0; r < 16; ++r) { const int c = (r & 3) + 8 * (r >> 2); p0[r] = tb[c]; p1[r] = tb[c + 32]; } \
            } \
            qkt<BUF, NQ>(p0, p1, K_lds, r32, hi, qr); \
            if (KIND == KIND_B && kb_ + KVBLK - 1 > qlo) {        \
                const int dq = qpos - kb_ - 4 * hi; const float NEG = -__builtin_inff(); \
                _Pragma("unroll") for (int r = 0; r < 16; ++r) { const int c = (r & 3) + 8 * (r >> 2); if (dq - c < 0) p0[r] = NEG; if (dq - c - 32 < 0) p1[r] = NEG; } } \
            softmax_nomax(p0, p1, l_reg, pa0, pa1, pa2, pa3); \
            SBAR(); pv_tile<BUF>(o, vb0, pa0, pa1, pa2, pa3); \
        } \
        if ((t_) > tl) { asm volatile("s_waitcnt vmcnt(0)" ::: "memory"); SWRITE((BUF) ^ 1); } \
        __syncthreads(); } while (0)
    int t = tmax;
    for (; t >= tl + 1; t -= 2) { TILE_STEP(0, t); TILE_STEP(1, t - 1); }
#undef TILE_STEP
#undef SLOAD
#undef SWRITE
    l_out = l_reg;
}

__device__ __forceinline__ void store_o_rows(GAS bf16* Orow  , int hi, const f32x16 (&v)[4]) {
    GAS char* p = (GAS char*)Orow + (hi ? 16 : 0);
#pragma unroll
    for (int d0 = 0; d0 < 4; ++d0)
#pragma unroll
        for (int g = 0; g < 4; g += 2) {
            unsigned ax = cvtpk(v[d0][4 * g], v[d0][4 * g + 1]), ay = cvtpk(v[d0][4 * g + 2], v[d0][4 * g + 3]);
            unsigned bx = cvtpk(v[d0][4 * g + 4], v[d0][4 * g + 5]), by = cvtpk(v[d0][4 * g + 6], v[d0][4 * g + 7]);
            auto rx = __builtin_amdgcn_permlane32_swap(ax, bx, false, false); auto ry = __builtin_amdgcn_permlane32_swap(ay, by, false, false);
            *(GAS u32x4*)(p + 16 * (4 * d0 + g)) = (u32x4){rx[0], ry[0], rx[1], ry[1]}; }
}
}

__device__ __forceinline__ void attn_unit_B(Frame& F, const att::UnitDesc d, int tid) {
    using namespace att;
    asm volatile("" : "+v"(tid));
    LAS char* lds = (LAS char*)F.lds + RING_OFF;
    const int wid = __builtin_amdgcn_readfirstlane(tid >> 6), lane = tid & 63, r32 = lane & 31, hi = lane >> 5;
    LAS float* tbl = (LAS float*)(lds + L_TBL);
    const GAS bf16* Z = (const GAS bf16*)(F.ws + WS_Z);
    const int Q0 = d.qb * QB; const size_t seq0 = (size_t)d.b * SEQ; const float LOG2E = 1.4426950408889634f;
    f32x16 o[4]; float l_reg;
    auto build = [&]() {
    { const GAS float* lf = (const GAS float*)(F.ws + WS_LOGF); const int n = Q0 + QB, p0 = 4 * tid;
      float v0 = 0.f, v1 = 0.f, v2 = 0.f, v3 = 0.f;
      if (p0 < n) { v0 = lf[(seq0 + p0) * 4 + d.h]; v1 = lf[(seq0 + p0 + 1) * 4 + d.h]; v2 = lf[(seq0 + p0 + 2) * 4 + d.h]; v3 = lf[(seq0 + p0 + 3) * 4 + d.h]; }
      v1 += v0; v2 += v1; v3 += v2;
      float sc = v3;
#pragma unroll
      for (int o = 1; o < 64; o <<= 1) { const float t = shfl_lane(sc, (lane - o) & 63); if (lane >= o) sc += t; }
      if (lane == 63) tbl[2100 + wid] = sc;
      __syncthreads();
      float off = sc - v3;
#pragma unroll
      for (int w = 0; w < NWAVES; ++w) off += (w < wid) ? tbl[2100 + w] : 0.f;
      if (p0 < n) *(LAS f32x4*)(tbl + p0) = (f32x4){-LOG2E * (v0 + off), -LOG2E * (v1 + off), -LOG2E * (v2 + off), -LOG2E * (v3 + off)}; }
    };
    const GAS bf16* base = Z + seq0 * ZQ;
    attn_pass<KIND_B, 128>(base + 1536 + d.h * 128, base + 2048 + d.h * 128, base + 2560 + d.h * 128, Q0, lds, tid, o, l_reg, 0.08838834764831845f * LOG2E, build);
    { const float il = 1.0f / l_reg;
#pragma unroll
      for (int d0 = 0; d0 < 4; ++d0) o[d0] *= il; }
    store_o_rows((GAS bf16*)(F.ws + WS_OA) + (seq0 + Q0 + wid * 32 + r32) * 1792 + 512 + d.h * 128, hi, o);
}
__device__ __forceinline__ void attn_unit_C(Frame& F, const att::UnitDesc d, int tid) {
    using namespace att;
    asm volatile("" : "+v"(tid));
    LAS char* lds = (LAS char*)F.lds + RING_OFF;
    const int wid = __builtin_amdgcn_readfirstlane(tid >> 6), lane = tid & 63, r32 = lane & 31, hi = lane >> 5;
    LAS float* tbl = (LAS float*)(lds + L_TBL);
    const GAS bf16* Z = (const GAS bf16*)(F.ws + WS_Z);
    const int Q0 = d.qb * QB; const size_t seq0 = (size_t)d.b * SEQ; const float LOG2E = 1.4426950408889634f;
    f32x16 o[4]; float l_reg;
    const float slope2 = exp2f(-8.0f * (float)(d.h + 1) / 6.0f) * LOG2E;
    auto build = [&]() {
    for (int i = tid; i < TBL_N; i += NWAVES * 64) { const int D = 2047 - i; float v;
        if (D < 0) v = -__builtin_inff();
        else { const int cnt = (D <= 128 ? 1 : 0) + (((D & 3) == 0 && D <= 512) ? 1 : 0) + (((D & 15) == 0) ? 1 : 0);
               v = cnt == 0 ? -__builtin_inff() : (-slope2 * (float)D + (cnt == 1 ? 0.f : cnt == 2 ? 1.0f : 1.5849625007211562f)); }
        tbl[i] = v; }
    };
    const GAS bf16* base = Z + seq0 * ZQ;
    attn_pass<KIND_C, 128>(base + 3072 + d.h * 128, base + 3840 + d.h * 128, base + 4608 + d.h * 128, Q0, lds, tid, o, l_reg, 0.08838834764831845f * LOG2E, build, slope2);
    { const float il = 1.0f / l_reg;
#pragma unroll
      for (int d0 = 0; d0 < 4; ++d0) o[d0] *= il; }
    store_o_rows((GAS bf16*)(F.ws + WS_OA) + (seq0 + Q0 + wid * 32 + r32) * 1792 + 1024 + d.h * 128, hi, o);
}
__device__ __forceinline__ void attn_unit_A(Frame& F, const att::UnitDesc d, int tid, int layer, const float lam, const float lam_init) {
    using namespace att;
    asm volatile("" : "+v"(tid));
    LAS char* lds = (LAS char*)F.lds + RING_OFF;
    const int wid = __builtin_amdgcn_readfirstlane(tid >> 6), lane = tid & 63, r32 = lane & 31, hi = lane >> 5;
    LAS float* tbl = (LAS float*)(lds + L_TBL);
    const GAS bf16* Z = (const GAS bf16*)(F.ws + WS_Z);
    const GAS char* scrb = (const GAS char*)(F.ws + WS_ASCR + (size_t)F.bx * 131072 + (size_t)wid * 16384);
    const unsigned scrl = (unsigned)lane * 16u;
    const GAS float* gsub = (const GAS float*)KIN(11) + layer * 128;
    const int Q0 = d.qb * QB; const size_t seq0 = (size_t)d.b * SEQ; const float LOG2E = 1.4426950408889634f;
    f32x16 o[4]; float l_reg;
    const float slope2 = exp2f(-2.0f * (float)(d.h + 1)) * LOG2E;
    auto build = [&]() { for (int i = tid; i < TBL_N; i += NWAVES * 64) { const int D = 2047 - i; tbl[i] = D < 0 ? -__builtin_inff() : -slope2 * (float)D; } };
    const GAS bf16* base = Z + seq0 * ZQ;
    attn_pass<KIND_A, 64>(base + d.h * 128, base + 512 + d.h * 128, base + 1024 + d.h * 128, Q0, lds, tid, o, l_reg, 0.125f * LOG2E, build, slope2);
    { const float il = 1.0f / l_reg;
#pragma unroll
      for (int d0 = 0; d0 < 4; ++d0)
#pragma unroll
          for (int g = 0; g < 4; ++g) *(GAS f32x4*)(scrb + (size_t)((4 * d0 + g) * 64) * 16 + scrl) = (f32x4){o[d0][4 * g] * il, o[d0][4 * g + 1] * il, o[d0][4 * g + 2] * il, o[d0][4 * g + 3] * il}; }
    asm volatile("" ::: "memory");
    attn_pass<KIND_A, 64>(base + d.h * 128 + 64, base + 512 + d.h * 128 + 64, base + 1024 + d.h * 128, Q0, lds, tid, o, l_reg, 0.125f * LOG2E, NoTable(), slope2);
    { const float il = lam / l_reg; float ssq = 0.f;
#pragma unroll
      for (int d0 = 0; d0 < 4; ++d0)
#pragma unroll
          for (int g = 0; g < 4; ++g) { const f32x4 o0 = *(const GAS f32x4*)(scrb + (size_t)((4 * d0 + g) * 64) * 16 + scrl);
#pragma unroll
              for (int j = 0; j < 4; ++j) { const float v = o0[j] - o[d0][4 * g + j] * il; o[d0][4 * g + j] = v; ssq += v * v; } }
      { auto rr = __builtin_amdgcn_permlane32_swap(__float_as_uint(ssq), __float_as_uint(ssq), false, false); ssq = __uint_as_float(rr[0]) + __uint_as_float(rr[1]); }
      const float rs = (1.0f / sqrtf(ssq * (1.0f / 128.0f) + EPS)) * (1.0f - lam_init);
#pragma unroll
      for (int d0 = 0; d0 < 4; ++d0)
#pragma unroll
          for (int g = 0; g < 4; ++g) { const f32x4 gv = *(const GAS f32x4*)(gsub + 32 * d0 + 8 * g + 4 * hi);
#pragma unroll
              for (int j = 0; j < 4; ++j) o[d0][4 * g + j] *= rs * gv[j]; } }
    store_o_rows((GAS bf16*)(F.ws + WS_OA) + (seq0 + Q0 + wid * 32 + r32) * 1792 + d.h * 128, hi, o);
}
__device__ __forceinline__ void p_attn(Frame& F, int layer, int qword) {
    using namespace att;
    const int lane = F.lane;
    gu32* queue = F.ctl + CW_QUEUE + 64 * layer + qword;
    const float lam_init = 0.8f - 0.6f * expf(-0.3f * (float)layer);
    const float lam = expf(wave_sum(((const GAS float*)KIN(7))[layer * 64 + lane] * ((const GAS float*)KIN(8))[layer * 64 + lane]))
                    - expf(wave_sum(((const GAS float*)KIN(9))[layer * 64 + lane] * ((const GAS float*)KIN(10))[layer * 64 + lane])) + lam_init;
    if (F.tid == 0) F.MISC[4] = __hip_atomic_fetch_add(queue, 1u, RLX_AGENT);
    __syncthreads();
    int u = (int)F.MISC[4];
    while (u < NUNITS) {
        unsigned nxt = 0u; if (F.tid == 0) nxt = __hip_atomic_fetch_add(queue, 1u, RLX_AGENT);
        const UnitDesc d = decode_unit(u);
        if (d.kind == KIND_B) attn_unit_B(F, d, F.tid);
        else if (d.kind == KIND_C) attn_unit_C(F, d, F.tid);
        else attn_unit_A(F, d, F.tid, layer, lam, lam_init);
        if (F.tid == 0) F.MISC[4] = nxt;
        __syncthreads();
        u = (int)F.MISC[4];
    }
}
#ifndef WGM_P1
#define WGM_P1 4
#define WGM_P4 4
#define WGM_P5 4
#define WGM_P7 4
#define WGM_P8 4
#endif
#ifndef MK_PER_PHASE
#define MK_PER_PHASE 0
#endif
__global__ void __launch_bounds__(NWAVES * 64, 2) mk_fwd(Args args) {
    extern __shared__ __attribute__((aligned(16))) unsigned char lds[];
    Frame F;
    F.lds = (LAS unsigned char*)lds;
    F.MISC = (volatile LAS unsigned*)(F.lds + MISC_OFF);
    F.tid = threadIdx.x; F.lane = F.tid & 63; F.wave = __builtin_amdgcn_readfirstlane(F.tid >> 6);
    F.G = gridDim.x; F.bx = blockIdx.x; F.vcu = (F.bx % 8) * (F.G / 8) + F.bx / 8;
    F.ws = args.ws; F.out = args.out; F.ctl = (gu32*)(args.ws + WS_CTL);
    F.args = &args;
    if (F.tid < 64) ((LAS unsigned*)(F.lds + MISC_OFF))[F.tid] = 0u;
    __syncthreads();
    XcdBarrier bar; bar.bar = (unsigned*)(F.ctl + CW_BAR); bar.x = 0; bar.st = nullptr;
    if (!MK_PER_PHASE) bar = xcd_barrier_post((unsigned*)(F.ctl + CW_BAR), F.MISC + 8);
    const int lo = args.gp_lo, hi = args.gp_hi;
#define IN(k) (lo <= (k) && (k) < hi)
#define PH_ENTER() do { asm volatile("" : "+v"(F.tid), "+s"(F.bx), "+s"(F.ws), "+s"(F.out)); F.lane = F.tid & 63; F.wave = __builtin_amdgcn_readfirstlane(F.tid >> 6); \
    F.vcu = (F.bx % 8) * (F.G / 8) + F.bx / 8; } while (0)
#define SEAM(k) do { if ((k) + 1 < hi) { if (MK_PER_PHASE) { if (F.tid == 0) __hip_atomic_store(F.ctl + 0, 0xBADBA0u, RLX_AGENT); } else xcd_barrier(bar); } } while (0)

#define Hb ((bf16*)(F.ws + WS_H))
#define XBp ((bf16*)(F.ws + WS_XB))
    for (int layer = 0; layer < DEPTH; ++layer) {
        const int gp = layer * NPH; constexpr size_t WOFF = 0;
        if (IN(gp + 0)) { PH_ENTER();
            LAS float* wfb = (LAS float*)(F.lds + 98304);
            { const float* w_in = KIN(2) + (size_t)layer * DM * INC;
              for (int k = F.tid; k < DM; k += NWAVES * 64) *(LAS f32x4*)(wfb + 4 * k) = *(const GAS f32x4*)((const GAS float*)w_in + (size_t)k * INC + FB_COL); }
            if (layer == 0) { wmax_scan(F, 0, F.bx * NWAVES + F.wave, F.G * NWAVES);
              __syncthreads(); if (!MK_PER_PHASE) xcd_barrier(bar); PH_ENTER(); }
            p_weights(F, layer);
            __syncthreads();
            const float* g = KIN(1) + layer * DM; const float* bfg = KIN(3) + layer * 4; float* logf = (float*)(F.ws + WS_LOGF);
            if (layer == 0) p_norm<true, true>(F, KIN(0), g, Hb, XBp, bfg, logf, wfb);
            else p_norm<true, false>(F, nullptr, g, Hb, XBp, bfg, logf, wfb);
            __syncthreads();
            SEAM(gp + 0);
        }
        if (IN(gp + 1)) { PH_ENTER();
            pg8::Gemm g{Hb, (const bf16*)(F.ws + WOFF + WS_WIN), MTOK, 14 * 256, DM, DM}; pg8::StaticOrder S; S.init(MTOK, 14 * 256, F.G, F.bx, WGM_P1);
            LAS float* gl = (LAS float*)(F.lds + MISC_OFF + 1024);
            for (int i = F.tid; i < 768; i += NWAVES * 64) { const int kd = i >> 7, e = i & 127; const GAS float* src = (const GAS float*)(kd == 0 ? KIN(5) : kd == 1 ? KIN(6) : kd == 2 ? KIN(12) : kd == 3 ? KIN(13) : kd == 4 ? KIN(14) : KIN(15));
                gl[i] = (kd < 2 ? src[layer * 64 + (e & 63)] : src[layer * 128 + e]) * (kd == 0 ? 0.125f * 1.4426950408889634f : (kd == 2 || kd == 4) ? 0.08838834764831845f * 1.4426950408889634f : 1.0f); }
            __syncthreads();
            { pg8::Gemm g8{(const bf16*)(F.ws + WS_H8), (const bf16*)(F.ws + WOFF + WS_W8), MTOK, GWD + 7 * 256, DM / 2, DM / 2}; pg8::StaticOrder S8; S8.init(MTOK, GWD + 7 * 256, F.G, F.bx, WGM_P1);
              { const int zn = (MTOK / 256) * 14, zc0 = zn - ((zn + F.G - 1) / F.G - 1) * F.G; if (zc0 > 0 && zc0 < F.G) { S8.bal_rounds = S8.nwg / F.G - 1; S8.bal_from = zc0; } }
              const float wsc8 = __uint_as_float(__hip_atomic_load(F.ctl + CW_WMAX + layer, __ATOMIC_RELAXED, __HIP_MEMORY_SCOPE_AGENT)) * (-1.4426950408889634f / 127.0f);
              pg8::EpiG8 E8{(bf16*)(F.ws + WS_G), KIN(4) + (size_t)layer * GWD, (const float*)(F.ws + WS_RSC), wsc8, (bf16*)(F.ws + WS_Z), wsc8 * (-1.0f / 1.4426950408889634f)};
              pg8::gemm_phase<pg8::EpiG8, pg8::StaticOrder, true, true>(F.lds + RING_OFF, g8, S8, E8, F.tid);
              { const int c0 = S8.nwg - (S8.nwg / F.G) * F.G; PH_ENTER();
                if (layer + 1 < DEPTH && c0 > 0 && F.bx >= c0) wmax_scan(F, layer + 1, (F.bx - c0) * NWAVES + F.wave, (F.G - c0) * NWAVES); } }
            PH_ENTER();
            pg8::EpiZ E{(bf16*)(F.ws + WS_Z), (bf16*)(F.ws + WS_G), KIN(4) + (size_t)layer * GWD, (LAS float*)(F.lds + EPI_OFF), gl};
            pg8::gemm_phase<pg8::EpiZ, pg8::StaticOrder, true, true>(F.lds + RING_OFF, g, S, E, F.tid);
            SEAM(gp + 1);
        }
        if (IN(gp + 3)) { PH_ENTER();
            p_attn(F, layer, 0);
            __syncthreads(); SEAM(gp + 3); }
        if (IN(gp + 4)) { PH_ENTER();
#define Gt ((const bf16*)(F.ws + WS_G))
            { pg8::Gemm g{(const bf16*)(F.ws + WS_OA), (const bf16*)(F.ws + WOFF + WS_WUA), MTOK, DM, 1792, 1792}; pg8::StaticOrder S; S.init(MTOK, DM, F.G, F.bx, WGM_P4);
              pg8::EpiMergeCat E{Gt, Hb, 8, 16}; pg8::gemm_phase<pg8::EpiMergeCat, pg8::StaticOrder, true, true>(F.lds + RING_OFF, g, S, E, F.tid); }
            SEAM(gp + 4);
        }
        if (IN(gp + 5)) { PH_ENTER();
            pg8::Gemm g{Hb, (const bf16*)(F.ws + WOFF + WS_WOUT), MTOK, DM, DM, DM}; pg8::StaticOrder S; S.init(MTOK, DM, F.G, F.bx, WGM_P5);
            pg8::EpiResid<false, false, true> E{XBp, nullptr, (float*)(F.ws + WS_SSQ), (LAS float*)(F.lds + EPI_OFF)};
            pg8::gemm_phase<pg8::EpiResid<false, false, true>, pg8::StaticOrder, true, true>(F.lds + RING_OFF, g, S, E, F.tid);
            SEAM(gp + 5);
        }
        if (IN(gp + 7)) { PH_ENTER();
            pg8::Gemm g{XBp, (const bf16*)(F.ws + WOFF + WS_WFI), MTOK, DFF, DM, DM}; pg8::StaticOrder S; S.init(MTOK, DFF, F.G, F.bx, WGM_P7);
            pg8::EpiRelu2 E{(bf16*)(F.ws + WS_U), DFF};
            pg8::gemm_phase<pg8::EpiRelu2, pg8::StaticOrder, true, true>(F.lds + RING_OFF, g, S, E, F.tid);
            SEAM(gp + 7);
        }
        if (IN(gp + 8)) { PH_ENTER();
            pg8::Gemm g{(const bf16*)(F.ws + WS_U), (const bf16*)(F.ws + WOFF + WS_WFO), MTOK, DM, DFF, DFF}; pg8::StaticOrder S; S.init(MTOK, DM, F.G, F.bx, WGM_P8);
            if (layer + 1 < DEPTH) { pg8::EpiResid<false, true, false> E{XBp, nullptr, (float*)(F.ws + WS_SSQ), nullptr}; pg8::gemm_phase<pg8::EpiResid<false, true, false>, pg8::StaticOrder, true, true>(F.lds + RING_OFF, g, S, E, F.tid); }
            else { pg8::EpiResid<true, true, false> E{XBp, F.out, (float*)(F.ws + WS_SSQ), nullptr}; pg8::gemm_phase<pg8::EpiResid<true, true, false>, pg8::StaticOrder, true, true>(F.lds + RING_OFF, g, S, E, F.tid); }
            SEAM(gp + 8);
        }
    }
#undef IN
#undef SEAM
#undef Hb
#undef XBp
#undef Gt
}

extern "C" void kernel_launch(void* const* d_in, const int* in_sizes, int n_in, void* d_out, int out_size, void* d_ws, size_t ws_size, hipStream_t stream) {
    static int grid = 0;
    if (grid == 0) {
        if (n_in != 23 || in_sizes[0] != MTOK * DM || out_size != MTOK * DM || ws_size < WS_END) { fprintf(stderr, "kernel_launch: unexpected shapes (n_in %d, in0 %d, out %d, ws %zu < %zu); nothing launched\n", n_in, n_in > 0 ? in_sizes[0] : -1, out_size, ws_size, (size_t)WS_END); grid = -1; return; }
        int dev = 0, cus = 0, per_cu = 0;
        if (hipGetDevice(&dev) != hipSuccess || hipDeviceGetAttribute(&cus, hipDeviceAttributeMultiprocessorCount, dev) != hipSuccess) { grid = -1; return; }
        if (hipFuncSetAttribute((const void*)mk_fwd, hipFuncAttributeMaxDynamicSharedMemorySize, LDS_BYTES) != hipSuccess) { fprintf(stderr, "kernel_launch: hipFuncSetAttribute failed\n"); grid = -1; return; }
        if (hipOccupancyMaxActiveBlocksPerMultiprocessor(&per_cu, (const void*)mk_fwd, NWAVES * 64, LDS_BYTES) != hipSuccess || per_cu < 1)
            fprintf(stderr, "kernel_launch: note: occupancy query reports %d workgroups per CU\n", per_cu);
        (void)hipGetLastError();
        grid = (cus < 256 ? cus : 256) & ~7;
    }
    if (grid < 0) return;
    if (hipMemsetAsync((char*)d_ws + WS_CTL, 0, CTL_ZERO_BYTES, stream) != hipSuccess) { fprintf(stderr, "kernel_launch: memset failed\n"); return; }
    Args a{};
    for (int i = 0; i < 23; ++i) a.in[i] = (const float*)d_in[i];
    a.out = (float*)d_out; a.ws = (unsigned char*)d_ws;
#if MK_PER_PHASE
    for (int gp = 0; gp < DEPTH * NPH; ++gp) { if (gp % NPH == 2 || gp % NPH == 6) continue; a.gp_lo = gp; a.gp_hi = gp + 1; hipLaunchKernelGGL(mk_fwd, dim3(grid), dim3(NWAVES * 64), LDS_BYTES, stream, a); }
#else
    a.gp_lo = 0; a.gp_hi = DEPTH * NPH;
    hipLaunchKernelGGL(mk_fwd, dim3(grid), dim3(NWAVES * 64), LDS_BYTES, stream, a);
#endif
    const hipError_t le = hipPeekAtLastError();
    if (le != hipSuccess) fprintf(stderr, "kernel_launch: launch failed: %s\n", hipGetErrorName(le));
}
```

```cpp
#include <hip/hip_runtime.h>
#include <cstdio>
#include <cstdint>
namespace pg8 {
#define PG8_LAS __attribute__((address_space(3)))
typedef unsigned short bf16_t;
typedef short bf16x8 __attribute__((ext_vector_type(8)));
typedef float f32x4 __attribute__((ext_vector_type(4)));
typedef unsigned u32x4 __attribute__((ext_vector_type(4)));
constexpr int BM = 256, BK = 64, HALF = 128, HTB = HALF * BK * 2  , STAGE_BYTES = 8 * HTB, NXCD = 8, WGM = 8;

__host__ __device__ __forceinline__ int lds_byte(int r, int c) { const int st = (r >> 4) * 2 + (c >> 5), rr = r & 15, cc = c & 31, ob = rr * 64 + cc * 2; return st * 1024 + (ob ^ (((ob >> 9) & 1) << 5)); }
__host__ __device__ __forceinline__ void stage_rc(int b, int& R, int& C) { const int st = b / 1024, sb = b % 1024, swz = sb ^ (((sb >> 9) & 1) << 5); R = (st >> 1) * 16 + swz / 64; C = (st & 1) * 32 + (swz % 64) / 2; }
__host__ __device__ __forceinline__ int perm32(int rho) { const int n = rho >> 4, i = rho & 15; return 8 * (i >> 2) + 4 * n + (i & 3); }

struct Unit { int pm, pn; };
struct Gemm { const bf16_t* A; const bf16_t* Bt; int M, N, K, lda; };

struct StaticOrder {
    int nM, nN, nwg, G, c, wgm;
    __host__ __device__ void init(int M, int N, int G_, int c_, int wgm_ = WGM) { nM = M / BM; nN = N / BM; nwg = nM * nN; G = G_; c = c_; wgm = wgm_; }
    int bal_rounds = 1 << 30, bal_from = 0;
    __host__ __device__ bool next(int i, Unit& u) const {
        long L;
        if (i < bal_rounds) L = (long)i * G + c;
        else { if (c < bal_from) return false; L = (long)bal_rounds * G + (long)(i - bal_rounds) * (G - bal_from) + (c - bal_from); }
        if (L >= nwg) return false;
        int wgid = (int)L; { const int q = nwg / NXCD, r = nwg % NXCD, xcd = wgid % NXCD, off = wgid / NXCD; wgid = (xcd < r ? xcd * (q + 1) : r * (q + 1) + (xcd - r) * q) + off; }
        const int nig = wgm * nN, gid = wgid / nig, fm = gid * wgm, gsz = (nM - fm) < wgm ? (nM - fm) : wgm;
        u.pm = fm + ((wgid % nig) % gsz); u.pn = (wgid % nig) / gsz; return true;
    }
    __device__ __forceinline__ void a_ready(const Unit&) const {}
    __device__ __forceinline__ void done(const Unit&) const {}
};

typedef __bf16 bf16x2_t __attribute__((ext_vector_type(2)));
typedef float f32x2_t __attribute__((ext_vector_type(2)));
__device__ __forceinline__ unsigned cvt_pk_bf16(float lo, float hi) { const f32x2_t v = {lo, hi}; return __builtin_bit_cast(unsigned, __builtin_convertvector(v, bf16x2_t)); }
#define PG8_GAS __attribute__((address_space(1)))
__device__ __forceinline__ u32x4 pack8(f32x4 v0, f32x4 v1) { u32x4 w; w.x = cvt_pk_bf16(v0[0], v0[1]); w.y = cvt_pk_bf16(v0[2], v0[3]); w.z = cvt_pk_bf16(v1[0], v1[1]); w.w = cvt_pk_bf16(v1[2], v1[3]); return w; }
__device__ __forceinline__ float sigm(float v) { return __builtin_amdgcn_rcpf(1.0f + __builtin_amdgcn_exp2f(-1.4426950408889634f * v)); }
__device__ __forceinline__ float sigm255(float v) { const float e = __builtin_amdgcn_exp2f(-1.4426950408889634f * v); return fmaxf(__builtin_amdgcn_rcpf(__builtin_fmaf(e, 1.0f / 255.0f, 1.0f / 255.0f)), 1.0f); }
__device__ __forceinline__ float sigm255n(float a, float nl  , float nb) { const float e = __builtin_amdgcn_exp2f(__builtin_fmaf(a, nl, nb)); return fmaxf(__builtin_amdgcn_rcpf(__builtin_fmaf(e, 1.0f / 255.0f, 1.0f / 255.0f)), 1.0f); }
__device__ __forceinline__ float ubyte(unsigned w, int j) { return (float)((w >> (8 * j)) & 0xffu); }

constexpr int E_ZQ = 5376, E_GW = 6144, E_DM = 2048, E_DFF = 8192;

template <int SEG> __device__ __forceinline__ void qknorm_store(const f32x4 (&acc)[2][2][4][2], const Unit& u, int wr, int wc, int fr, int fq, PG8_LAS float* P, const PG8_LAS float* gain, bf16_t* Z) {
    float ss[2][4][2];
#pragma unroll
    for (int ai = 0; ai < 2; ++ai)
#pragma unroll
        for (int m = 0; m < 4; ++m)
#pragma unroll
            for (int bj = 0; bj < 2; ++bj) { const f32x4 a = acc[ai][bj][m][0], b = acc[ai][bj][m][1];
                float s = (a[0] * a[0] + a[1] * a[1]) + (a[2] * a[2] + a[3] * a[3]) + (b[0] * b[0] + b[1] * b[1]) + (b[2] * b[2] + b[3] * b[3]);
                s += __int_as_float(__builtin_amdgcn_ds_swizzle(__float_as_int(s), (16 << 10) | 0x1f));
                auto rr = __builtin_amdgcn_permlane32_swap(__float_as_uint(s), __float_as_uint(s), false, false);
                ss[ai][m][bj] = __uint_as_float(rr[0]) + __uint_as_float(rr[1]); }
    if (fq == 0) {
#pragma unroll
        for (int ai = 0; ai < 2; ++ai)
#pragma unroll
            for (int m = 0; m < 4; ++m)
#pragma unroll
                for (int bj = 0; bj < 2; ++bj) P[((ai * HALF + wr * 64 + m * 16 + fr) * 2 + bj) * 4 + wc] = ss[ai][m][bj];
    }
    asm volatile("s_waitcnt lgkmcnt(0)" ::: "memory"); __builtin_amdgcn_s_barrier(); asm volatile("" ::: "memory");
    const int gidx = (32 * wc + 8 * fq) & (SEG - 1);
    const f32x4 ga0 = *(const PG8_LAS f32x4*)(gain + gidx), ga1 = *(const PG8_LAS f32x4*)(gain + gidx + 4);
    const int row0 = u.pm * BM + wr * 64 + fr, col0 = u.pn * BM + wc * 32 + 8 * fq;
#pragma unroll
    for (int ai = 0; ai < 2; ++ai)
#pragma unroll
        for (int m = 0; m < 4; ++m) { PG8_GAS bf16_t* rowp = (PG8_GAS bf16_t*)Z + (size_t)(row0 + ai * HALF + m * 16) * E_ZQ + col0;
#pragma unroll
            for (int bj = 0; bj < 2; ++bj) { const f32x4 q = *(const PG8_LAS f32x4*)(P + ((ai * HALF + wr * 64 + m * 16 + fr) * 2 + bj) * 4);
                const float tot = SEG == 128 ? (q[0] + q[1]) + (q[2] + q[3]) : (wc < 2 ? q[0] + q[1] : q[2] + q[3]);
                const float r = 1.0f / sqrtf(tot * (1.0f / SEG) + 1e-6f);
                *(PG8_GAS u32x4*)(rowp + bj * HALF) = pack8(acc[ai][bj][m][0] * r * ga0, acc[ai][bj][m][1] * r * ga1); } }
}
struct EpiZ {
    static constexpr bool PERM = true, AFTER_DRAIN = false;
    bf16_t* Z; bf16_t* Gt; const float* bgate; PG8_LAS float* P; const PG8_LAS float* gains;
    __device__ __forceinline__ void operator()(const f32x4 (&acc)[2][2][4][2], const Unit& u, int wr, int wc, int fr, int fq) const {
        const int pn = u.pn < 4 ? u.pn : u.pn < 8 ? u.pn + 2 : u.pn + 4; Unit uz = u; uz.pn = pn;
        const int row0 = u.pm * BM + wr * 64 + fr; const int colt = pn * BM;
        if (colt < E_ZQ) {
            if (pn < 4) qknorm_store<64>(acc, uz, wr, wc, fr, fq, P, gains + (pn >> 1) * 128, Z);
            else if ((pn >= 6 && pn < 10) || (pn >= 12 && pn < 18)) qknorm_store<128>(acc, uz, wr, wc, fr, fq, P, gains + (pn < 8 ? 2 : pn < 10 ? 3 : pn < 15 ? 4 : 5) * 128, Z);
            else {
                const int col0 = colt + wc * 32 + 8 * fq;
#pragma unroll
                for (int ai = 0; ai < 2; ++ai)
#pragma unroll
                    for (int m = 0; m < 4; ++m) { PG8_GAS bf16_t* rowp = (PG8_GAS bf16_t*)Z + (size_t)(row0 + ai * HALF + m * 16) * E_ZQ + col0;
#pragma unroll
                        for (int bj = 0; bj < 2; ++bj) *(PG8_GAS u32x4*)(rowp + bj * HALF) = pack8(acc[ai][bj][m][0], acc[ai][bj][m][1]); }
            }
        } else {
            const int gc0 = colt - E_ZQ + wc * 32 + 8 * fq;
            f32x4 bv[2][2];
#pragma unroll
            for (int bj = 0; bj < 2; ++bj)
#pragma unroll
                for (int n = 0; n < 2; ++n) bv[bj][n] = *(const PG8_GAS f32x4*)((const PG8_GAS float*)bgate + gc0 + bj * HALF + 4 * n) * -1.4426950408889634f;
            PG8_GAS char* gp = (PG8_GAS char*)Gt + ((size_t)(u.pm * 24 + ((colt - E_ZQ) >> 8)) << 16) + (size_t)((wr * 4 + wc) * 1024) + (unsigned)((fq * 16 + fr) * 16);
#pragma unroll
            for (int ai = 0; ai < 2; ++ai)
#pragma unroll
                for (int m = 0; m < 4; ++m) { u32x4 w;
#pragma unroll
                    for (int bj = 0; bj < 2; ++bj) { unsigned w0 = 0u, w1 = 0u;
#pragma unroll
                        for (int j = 0; j < 4; ++j) { w0 = __builtin_amdgcn_cvt_pk_u8_f32(sigm255n(acc[ai][bj][m][0][j], -1.4426950408889634f, bv[bj][0][j]), j, w0); w1 = __builtin_amdgcn_cvt_pk_u8_f32(sigm255n(acc[ai][bj][m][1][j], -1.4426950408889634f, bv[bj][1][j]), j, w1); }
                        w[2 * bj] = w0; w[2 * bj + 1] = w1; }
                    __builtin_nontemporal_store(w, (PG8_GAS u32x4*)(gp + (ai * 4 + m) * 8192)); }
        }
    }
};
typedef int i32x4 __attribute__((ext_vector_type(4)));
struct EpiG8 {
    static constexpr bool PERM = true, AFTER_DRAIN = false, I8 = true;
    bf16_t* Gt; const float* bgate; const float* RSC; float wsc;
    bf16_t* Z; float wsv;
    __device__ __forceinline__ void operator()(const f32x4 (&acc)[2][2][4][2], const Unit& u, int wr, int wc, int fr, int fq) const {
        asm volatile("" : "+v"(fr), "+v"(fq));
        const int row0 = u.pm * BM + wr * 64 + fr; const int gc0 = u.pn * BM + wc * 32 + 8 * fq;
        if (u.pn >= 24) {
            const int vt = u.pn - 24, pnz = vt < 2 ? 4 + vt : vt < 4 ? 8 + vt : 14 + vt; const int col0 = pnz * BM + wc * 32 + 8 * fq;
#pragma unroll
            for (int ai = 0; ai < 2; ++ai)
#pragma unroll
                for (int m = 0; m < 4; ++m) { const float sc = ((const PG8_GAS float*)RSC)[row0 + ai * HALF + m * 16] * wsv;
                    PG8_GAS bf16_t* rowp = (PG8_GAS bf16_t*)Z + (size_t)(row0 + ai * HALF + m * 16) * E_ZQ + col0;
#pragma unroll
                    for (int bj = 0; bj < 2; ++bj) { const i32x4 a0 = __builtin_bit_cast(i32x4, acc[ai][bj][m][0]), a1 = __builtin_bit_cast(i32x4, acc[ai][bj][m][1]);
                        const f32x4 v0 = {(float)a0[0] * sc, (float)a0[1] * sc, (float)a0[2] * sc, (float)a0[3] * sc}, v1 = {(float)a1[0] * sc, (float)a1[1] * sc, (float)a1[2] * sc, (float)a1[3] * sc};
                        *(PG8_GAS u32x4*)(rowp + bj * HALF) = pack8(v0, v1); } }
            return; }
        f32x4 bv[2][2];
#pragma unroll
        for (int bj = 0; bj < 2; ++bj)
#pragma unroll
            for (int n = 0; n < 2; ++n) bv[bj][n] = *(const PG8_GAS f32x4*)((const PG8_GAS float*)bgate + gc0 + bj * HALF + 4 * n) * -1.4426950408889634f;
        float nl[2][4];
#pragma unroll
        for (int ai = 0; ai < 2; ++ai)
#pragma unroll
            for (int m = 0; m < 4; ++m) nl[ai][m] = ((const PG8_GAS float*)RSC)[row0 + ai * HALF + m * 16] * wsc;
        PG8_GAS char* gp = (PG8_GAS char*)Gt + ((size_t)(u.pm * 24 + u.pn) << 16) + (size_t)((wr * 4 + wc) * 1024) + (unsigned)((fq * 16 + fr) * 16);
#pragma unroll
        for (int ai = 0; ai < 2; ++ai)
#pragma unroll
            for (int m = 0; m < 4; ++m) { u32x4 w;
#pragma unroll
                for (int bj = 0; bj < 2; ++bj) { unsigned w0 = 0u, w1 = 0u; const i32x4 a0 = __builtin_bit_cast(i32x4, acc[ai][bj][m][0]), a1 = __builtin_bit_cast(i32x4, acc[ai][bj][m][1]);
#pragma unroll
                    for (int j = 0; j < 4; ++j) { w0 = __builtin_amdgcn_cvt_pk_u8_f32(sigm255n((float)a0[j], nl[ai][m], bv[bj][0][j]), j, w0); w1 = __builtin_amdgcn_cvt_pk_u8_f32(sigm255n((float)a1[j], nl[ai][m], bv[bj][1][j]), j, w1); }
                    w[2 * bj] = w0; w[2 * bj + 1] = w1; }
                __builtin_nontemporal_store(w, (PG8_GAS u32x4*)(gp + (ai * 4 + m) * 8192)); }
    }
};
__device__ __forceinline__ void unpack8(const u32x4 w, f32x4& a, f32x4& b) {
    a[0] = __uint_as_float(w.x << 16); a[1] = __uint_as_float(w.x & 0xffff0000u); a[2] = __uint_as_float(w.y << 16); a[3] = __uint_as_float(w.y & 0xffff0000u);
    b[0] = __uint_as_float(w.z << 16); b[1] = __uint_as_float(w.z & 0xffff0000u); b[2] = __uint_as_float(w.w << 16); b[3] = __uint_as_float(w.w & 0xffff0000u); }
struct EpiMergeCat {
    static constexpr bool PERM = true, AFTER_DRAIN = false, HOOK = true;
    const bf16_t* Gt; bf16_t* Out; int t1, t2;
    __device__ __forceinline__ bool at_hook(int t) const { return t == t1 || t == t2; }
    __device__ __forceinline__ void mid(f32x4 (&acc)[2][2][4][2], const Unit& u, int t, int wr, int wc, int fr, int fq) const {
        const int tnum = (t == t1) ? 0 : 8;
        const PG8_GAS char* gp = (const PG8_GAS char*)Gt + ((size_t)(u.pm * 24 + tnum + u.pn) << 16) + (size_t)((wr * 4 + wc) * 1024); const unsigned gL = (unsigned)((fq * 16 + fr) * 16);
#pragma unroll
        for (int ai = 0; ai < 2; ++ai) {
            u32x4 gn[4], gd[4];
#pragma unroll
            for (int m = 0; m < 4; ++m) { gn[m] = *(const PG8_GAS u32x4*)(gp + (ai * 4 + m) * 8192 + gL); gd[m] = *(const PG8_GAS u32x4*)(gp + (8 << 16) + (ai * 4 + m) * 8192 + gL); }
#pragma unroll
            for (int m = 0; m < 4; ++m)
#pragma unroll
                for (int bj = 0; bj < 2; ++bj)
#pragma unroll
                    for (int n = 0; n < 2; ++n)
#pragma unroll
                        for (int j = 0; j < 4; ++j) acc[ai][bj][m][n][j] *= ubyte(gn[m][2 * bj + n], j) * __builtin_amdgcn_rcpf(ubyte(gd[m][2 * bj + n], j));
            asm volatile("" ::: "memory"); }
    }
    __device__ __forceinline__ void operator()(const f32x4 (&acc)[2][2][4][2], const Unit& u, int wr, int wc, int fr, int fq) const {
        const size_t urow = (size_t)(u.pm * BM + wr * 64); const int ucol = u.pn * BM + wc * 32;
        const PG8_GAS char* gp = (const PG8_GAS char*)Gt + ((size_t)(u.pm * 24 + 16 + u.pn) << 16) + (size_t)((wr * 4 + wc) * 1024); const unsigned gL = (unsigned)((fq * 16 + fr) * 16);
        PG8_GAS char* oB = (PG8_GAS char*)Out + (urow * E_DM + ucol) * 2; const unsigned oL = (unsigned)(fr * E_DM + 8 * fq) * 2u;
#pragma unroll
        for (int ai = 0; ai < 2; ++ai) {
            u32x4 gw[4];
#pragma unroll
            for (int m = 0; m < 4; ++m) gw[m] = *(const PG8_GAS u32x4*)(gp + (ai * 4 + m) * 8192 + gL);
#pragma unroll
            for (int m = 0; m < 4; ++m)
#pragma unroll
                for (int bj = 0; bj < 2; ++bj) { f32x4 g0, g1;
#pragma unroll
                    for (int j = 0; j < 4; ++j) { g0[j] = ubyte(gw[m][2 * bj], j) * (1.0f / 255.0f); g1[j] = ubyte(gw[m][2 * bj + 1], j) * (1.0f / 255.0f); }
                    *(PG8_GAS u32x4*)(oB + (size_t)(ai * HALF + m * 16) * E_DM * 2 + bj * HALF * 2 + oL) = pack8(acc[ai][bj][m][0] * g0, acc[ai][bj][m][1] * g1); }
            asm volatile("" ::: "memory"); }
    }
};
template <bool FINAL, bool ROWSCALE, bool SUMSQ> struct EpiResid {
    static constexpr bool PERM = true, AFTER_DRAIN = false;
    bf16_t* XB; float* OUT; float* SSQ; PG8_LAS float* P;
    __device__ __forceinline__ void operator()(const f32x4 (&acc)[2][2][4][2], const Unit& u, int wr, int wc, int fr, int fq) const {
        const size_t urow = (size_t)(u.pm * BM + wr * 64); const int ucol = u.pn * BM + wc * 32;
        PG8_GAS char* xB = (PG8_GAS char*)XB + (urow * E_DM + ucol) * 2; const unsigned xL = (unsigned)(fr * E_DM + 8 * fq) * 2u;
        PG8_GAS char* oB = (PG8_GAS char*)OUT + (urow * E_DM + ucol) * 4; const unsigned oL = (unsigned)(fr * E_DM + 8 * fq) * 4u;
        const PG8_GAS char* sB = (const PG8_GAS char*)SSQ + urow * 32; const unsigned sL = (unsigned)fr * 32u;
#pragma unroll
        for (int ai = 0; ai < 2; ++ai) {
            u32x4 old[4][2]; f32x4 sq[4][2];
#pragma unroll
            for (int m = 0; m < 4; ++m) {
#pragma unroll
                for (int bj = 0; bj < 2; ++bj) old[m][bj] = *(const PG8_GAS u32x4*)(xB + (size_t)(ai * HALF + m * 16) * E_DM * 2 + bj * HALF * 2 + xL);
                if (ROWSCALE) { sq[m][0] = *(const PG8_GAS f32x4*)(sB + (size_t)(ai * HALF + m * 16) * 32 + sL); sq[m][1] = *(const PG8_GAS f32x4*)(sB + (size_t)(ai * HALF + m * 16) * 32 + 16 + sL); } }
#pragma unroll
            for (int m = 0; m < 4; ++m) {
                float sc = 1.f;
                if (ROWSCALE) { const f32x4 t = sq[m][0] + sq[m][1]; sc = __builtin_amdgcn_rcpf(((t[0] + t[1]) + (t[2] + t[3])) * (1.0f / E_DM) + 1e-6f); }
                float ss = 0.f;
#pragma unroll
                for (int bj = 0; bj < 2; ++bj) { f32x4 p0, p1; unpack8(old[m][bj], p0, p1);
                    const f32x4 v0 = p0 + acc[ai][bj][m][0] * sc, v1 = p1 + acc[ai][bj][m][1] * sc;
                    if (SUMSQ) ss += (v0[0] * v0[0] + v0[1] * v0[1]) + (v0[2] * v0[2] + v0[3] * v0[3]) + (v1[0] * v1[0] + v1[1] * v1[1]) + (v1[2] * v1[2] + v1[3] * v1[3]);
                    if (FINAL) { PG8_GAS char* op = oB + (size_t)(ai * HALF + m * 16) * E_DM * 4 + bj * HALF * 4 + oL; *(PG8_GAS f32x4*)op = v0; *(PG8_GAS f32x4*)(op + 16) = v1; }
                    else *(PG8_GAS u32x4*)(xB + (size_t)(ai * HALF + m * 16) * E_DM * 2 + bj * HALF * 2 + xL) = pack8(v0, v1); }
                if (SUMSQ) { ss += __int_as_float(__builtin_amdgcn_ds_swizzle(__float_as_int(ss), (16 << 10) | 0x1f));
                    auto rr = __builtin_amdgcn_permlane32_swap(__float_as_uint(ss), __float_as_uint(ss), false, false); ss = __uint_as_float(rr[0]) + __uint_as_float(rr[1]);
                    if (fq == 0) P[(ai * HALF + wr * 64 + m * 16 + fr) * 4 + wc] = ss; } }
            asm volatile("" ::: "memory"); }
        if (SUMSQ) {
            asm volatile("s_waitcnt lgkmcnt(0)" ::: "memory"); __builtin_amdgcn_s_barrier(); asm volatile("" ::: "memory");
            const int t = (wr * 4 + wc) * 64 + fq * 16 + fr;
            if (t < BM) { const f32x4 q = *(const PG8_LAS f32x4*)(P + t * 4); ((PG8_GAS float*)SSQ)[((size_t)u.pm * BM + t) * 8 + u.pn] = (q[0] + q[1]) + (q[2] + q[3]); }
        }
    }
};
struct EpiRelu2 {
    static constexpr bool PERM = true, AFTER_DRAIN = false;
    bf16_t* U; int ldc;
    __device__ __forceinline__ void operator()(const f32x4 (&acc)[2][2][4][2], const Unit& u, int wr, int wc, int fr, int fq) const {
        const int row0 = u.pm * BM + wr * 64 + fr, col0 = u.pn * BM + wc * 32 + 8 * fq;
#pragma unroll
        for (int ai = 0; ai < 2; ++ai)
#pragma unroll
            for (int m = 0; m < 4; ++m) { PG8_GAS bf16_t* rowp = (PG8_GAS bf16_t*)U + (size_t)(row0 + ai * HALF + m * 16) * ldc + col0;
#pragma unroll
                for (int bj = 0; bj < 2; ++bj) { f32x4 v0 = acc[ai][bj][m][0], v1 = acc[ai][bj][m][1];
#pragma unroll
                    for (int j = 0; j < 4; ++j) { const float a = fmaxf(v0[j], 0.f), b = fmaxf(v1[j], 0.f); v0[j] = a * a; v1[j] = b * b; }
                    __builtin_nontemporal_store(pack8(v0, v1), (PG8_GAS u32x4*)(rowp + bj * HALF)); } }
    }
};

template <class T, class = void> struct has_i8 { static constexpr bool value = false; };
template <class T> struct has_i8<T, decltype((void)T::I8)> { static constexpr bool value = true; };
template <bool I8> __device__ __forceinline__ f32x4 mma16(bf16x8 b, bf16x8 a, f32x4 c) {
    if constexpr (I8) return __builtin_bit_cast(f32x4, __builtin_amdgcn_mfma_i32_16x16x64_i8(__builtin_bit_cast(i32x4, b), __builtin_bit_cast(i32x4, a), __builtin_bit_cast(i32x4, c), 0, 0, 0));
    else return __builtin_amdgcn_mfma_f32_16x16x32_bf16(b, a, c, 0, 0, 0);
}
template <class T, class = void> struct has_hook { static constexpr bool value = false; };
template <class T> struct has_hook<T, decltype((void)T::HOOK)> { static constexpr bool value = true; };
template <class Epi, class Sched, bool ALIGN_EPI = false, bool SP2 = false>
__device__ __forceinline__ void gemm_phase(PG8_LAS unsigned char* lds, const Gemm g, const Sched& S, const Epi& E, const int tid) {
    const int wid = __builtin_amdgcn_readfirstlane(tid >> 6), lane = tid & 63, wr = wid >> 2, wc = wid & 3, fr = lane & 15, fq = lane >> 4;
    const int K = g.K, nt = K / BK, lda = g.lda;
    unsigned voffA[2], voffB[2];
#pragma unroll
    for (int i = 0; i < 2; ++i) { int R, C; stage_rc(tid * 16 + i * 8192, R, C); const int Rb = Epi::PERM ? ((R & ~31) + perm32(R & 31)) : R;
        voffA[i] = (unsigned)(R * lda + C) * 2u; voffB[i] = (unsigned)(Rb * K + C) * 2u; }
    const size_t kstep = (size_t)(BK * 2);
    const size_t hstepA = (size_t)HALF * lda * 2, hstepB = (size_t)HALF * K * 2;
    const size_t tstepA = 2 * hstepA, tstepB = 2 * hstepB;
    const unsigned ldsw = (unsigned)wid * 1024u;
    const int aoff = lds_byte(wr * 64 + fr, fq * 8), boff = lds_byte(wc * 32 + fr, fq * 8);
#define PG8_SA(b, h) (((b) * 2 + (h)) * HTB)
#define PG8_SB(b, h) ((4 + (b) * 2 + (h)) * HTB)
#define PG8_STAGE(bufoff, gbase, voff) do { _Pragma("unroll") for (int _i = 0; _i < 2; ++_i) \
        __builtin_amdgcn_global_load_lds((const unsigned*)((const char*)(gbase) + (voff)[_i]), (PG8_LAS unsigned*)(lds + (bufoff) + ldsw + _i * 8192), 16, 0, 0); } while (0)
#define PG8_LDA(dst, b, h) do { _Pragma("unroll") for (int m = 0; m < 4; ++m) _Pragma("unroll") for (int k = 0; k < 2; ++k) dst[m][k] = *(const PG8_LAS bf16x8*)(lds + PG8_SA(b, h) + aoff + m * 2048 + k * 1024); } while (0)
#define PG8_LDB(dst, b, h) do { _Pragma("unroll") for (int n = 0; n < 2; ++n) _Pragma("unroll") for (int k = 0; k < 2; ++k) dst[n][k] = *(const PG8_LAS bf16x8*)(lds + PG8_SB(b, h) + boff + n * 2048 + k * 1024); } while (0)
#define PG8_MMA(ai, bj, At, Bt) do { __builtin_amdgcn_s_setprio(1); _Pragma("unroll") for (int m = 0; m < 4; ++m) _Pragma("unroll") for (int n = 0; n < 2; ++n) _Pragma("unroll") for (int k = 0; k < 2; ++k) \
        acc[ai][bj][m][n] = mma16<has_i8<Epi>::value>(Bt[n][k], At[m][k], acc[ai][bj][m][n]); __builtin_amdgcn_s_setprio(0); } while (0)
#define PG8_WAIT_V(n) asm volatile("s_waitcnt vmcnt(" #n ")" ::: "memory")
#define PG8_WAIT_L(n) asm volatile("s_waitcnt lgkmcnt(" #n ")" ::: "memory")
#define PG8_BAR __builtin_amdgcn_s_barrier()
#define PG8_SCHED __builtin_amdgcn_sched_barrier(0)
    Unit cur, nxt; int ui = 0;
    if (!S.next(0, cur)) return;
    f32x4 acc[2][2][4][2];
#pragma unroll
    for (int a = 0; a < 2; ++a)
#pragma unroll
        for (int b = 0; b < 2; ++b)
#pragma unroll
            for (int m = 0; m < 4; ++m)
#pragma unroll
                for (int n = 0; n < 2; ++n) acc[a][b][m][n] = (f32x4){0.f, 0.f, 0.f, 0.f};
    bf16x8 At[4][2], B0[2][2], B1[2][2];
    const char* cA = (const char*)g.A + (size_t)cur.pm * tstepA; const char* cB = (const char*)g.Bt + (size_t)cur.pn * tstepB;
    S.a_ready(cur);
    if constexpr (SP2) {
        PG8_STAGE(PG8_SB(0, 0), cB, voffB); PG8_STAGE(PG8_SB(0, 1), cB + hstepB, voffB); PG8_STAGE(PG8_SA(0, 0), cA, voffA); PG8_STAGE(PG8_SA(0, 1), cA + hstepA, voffA);
        if (wr == 1) PG8_BAR;
        PG8_WAIT_V(2); PG8_BAR;
        PG8_STAGE(PG8_SB(1, 0), cB + kstep, voffB); PG8_STAGE(PG8_SA(1, 0), cA + kstep, voffA); PG8_STAGE(PG8_SB(1, 1), cB + hstepB + kstep, voffB);
        PG8_WAIT_V(6); PG8_BAR;
    } else {
        PG8_STAGE(PG8_SB(0, 0), cB, voffB); PG8_STAGE(PG8_SA(0, 0), cA, voffA); PG8_STAGE(PG8_SB(0, 1), cB + hstepB, voffB); PG8_STAGE(PG8_SA(0, 1), cA + hstepA, voffA);
        if (wr == 1) PG8_BAR;
        PG8_WAIT_V(4); PG8_BAR;
        PG8_STAGE(PG8_SB(1, 0), cB + kstep, voffB); PG8_STAGE(PG8_SA(1, 0), cA + kstep, voffA); PG8_STAGE(PG8_SB(1, 1), cB + hstepB + kstep, voffB);
        PG8_WAIT_V(6); PG8_BAR;
    }
    for (;;) {
        const bool has_next = S.next(ui + 1, nxt);
        const char* nA = has_next ? (const char*)g.A + (size_t)nxt.pm * tstepA : cA; const char* nB = has_next ? (const char*)g.Bt + (size_t)nxt.pn * tstepB : cB;
        for (int t = 0; t < nt; t += 2) {
            const bool last = (t == nt - 2);
            const char* a1 = cA + (size_t)(t + 1) * kstep;
            const char* a2 = last ? nA : cA + (size_t)(t + 2) * kstep; const char* b2 = last ? nB : cB + (size_t)(t + 2) * kstep;
            const char* a3 = a2 + kstep; const char* b3 = b2 + kstep;
            if (last && has_next) S.a_ready(nxt);
            if constexpr (has_hook<Epi>::value) { if (E.at_hook(t)) E.mid(acc, cur, t, wr, wc, fr, fq); }
            if constexpr (SP2) {
            PG8_LDB(B0, 0, 0); PG8_LDB(B1, 0, 1); PG8_SCHED; PG8_LDA(At, 0, 0); PG8_STAGE(PG8_SA(1, 1), a1 + hstepA, voffA);
            PG8_WAIT_V(8); PG8_WAIT_L(0); PG8_BAR; PG8_MMA(0, 0, At, B0); PG8_MMA(0, 1, At, B1); PG8_BAR; PG8_SCHED;
            PG8_LDA(At, 0, 1); PG8_STAGE(PG8_SB(0, 0), b2, voffB); PG8_STAGE(PG8_SB(0, 1), b2 + hstepB, voffB); PG8_STAGE(PG8_SA(0, 0), a2, voffA);
            PG8_WAIT_V(8); PG8_WAIT_L(0); PG8_BAR; PG8_MMA(1, 0, At, B0); PG8_MMA(1, 1, At, B1); PG8_BAR; PG8_SCHED;
            PG8_LDB(B0, 1, 0); PG8_LDB(B1, 1, 1); PG8_SCHED; PG8_LDA(At, 1, 0); PG8_STAGE(PG8_SA(0, 1), a2 + hstepA, voffA);
            PG8_WAIT_V(8); PG8_WAIT_L(0); PG8_BAR; PG8_MMA(0, 0, At, B0); PG8_MMA(0, 1, At, B1); PG8_BAR; PG8_SCHED;
            PG8_LDA(At, 1, 1); PG8_STAGE(PG8_SB(1, 0), b3, voffB); PG8_STAGE(PG8_SB(1, 1), b3 + hstepB, voffB); PG8_STAGE(PG8_SA(1, 0), a3, voffA);
            PG8_WAIT_V(8); PG8_WAIT_L(0); PG8_BAR; PG8_MMA(1, 0, At, B0); PG8_MMA(1, 1, At, B1); PG8_BAR; PG8_SCHED;
            } else {
            PG8_LDB(B0, 0, 0); PG8_SCHED; PG8_LDA(At, 0, 0); PG8_STAGE(PG8_SA(1, 1), a1 + hstepA, voffA);
            PG8_WAIT_L(8); PG8_BAR; PG8_WAIT_L(0); PG8_MMA(0, 0, At, B0); PG8_BAR; PG8_SCHED;
            PG8_LDB(B1, 0, 1); PG8_STAGE(PG8_SB(0, 0), b2, voffB);
            PG8_BAR; PG8_WAIT_L(0); PG8_MMA(0, 1, At, B1); PG8_BAR;
            PG8_LDA(At, 0, 1); PG8_STAGE(PG8_SA(0, 0), a2, voffA);
            PG8_BAR; PG8_WAIT_L(0); PG8_MMA(1, 0, At, B0); PG8_BAR; PG8_SCHED;
            PG8_STAGE(PG8_SB(0, 1), b2 + hstepB, voffB);
            PG8_WAIT_V(6); PG8_BAR; PG8_MMA(1, 1, At, B1); PG8_BAR;
            PG8_LDB(B0, 1, 0); PG8_SCHED; PG8_LDA(At, 1, 0); PG8_STAGE(PG8_SA(0, 1), a2 + hstepA, voffA);
            PG8_WAIT_L(8); PG8_BAR; PG8_WAIT_L(0); PG8_MMA(0, 0, At, B0); PG8_BAR; PG8_SCHED;
            PG8_LDB(B1, 1, 1); PG8_STAGE(PG8_SB(1, 0), b3, voffB);
            PG8_BAR; PG8_WAIT_L(0); PG8_MMA(0, 1, At, B1); PG8_BAR;
            PG8_LDA(At, 1, 1); PG8_STAGE(PG8_SA(1, 0), a3, voffA);
            PG8_BAR; PG8_WAIT_L(0); PG8_MMA(1, 0, At, B0); PG8_BAR; PG8_SCHED;
            PG8_STAGE(PG8_SB(1, 1), b3 + hstepB, voffB);
            PG8_WAIT_V(6); PG8_BAR; PG8_MMA(1, 1, At, B1); PG8_BAR;
            }
        }
        if constexpr (ALIGN_EPI) { if (wr == 0) PG8_BAR; }
        E(acc, cur, wr, wc, fr, fq); S.done(cur);
        if (!has_next) break;
#pragma unroll
        for (int a = 0; a < 2; ++a)
#pragma unroll
            for (int b = 0; b < 2; ++b)
#pragma unroll
                for (int m = 0; m < 4; ++m)
#pragma unroll
                    for (int n = 0; n < 2; ++n) acc[a][b][m][n] = (f32x4){0.f, 0.f, 0.f, 0.f};
        cur = nxt; cA = nA; cB = nB; ++ui;
        if constexpr (ALIGN_EPI) { if (wr == 1) PG8_BAR; }
    }
    PG8_WAIT_V(0);
    if constexpr (!ALIGN_EPI) { if (wr == 0) PG8_BAR; }
    PG8_BAR;
#undef PG8_SA
#undef PG8_SB
#undef PG8_STAGE
#undef PG8_LDA
#undef PG8_LDB
#undef PG8_MMA
#undef PG8_WAIT_V
#undef PG8_WAIT_L
#undef PG8_BAR
#undef PG8_SCHED
}
}
#define GAS __attribute__((address_space(1)))
#define LAS __attribute__((address_space(3)))
typedef unsigned short bf16;
typedef unsigned v4u __attribute__((ext_vector_type(4)));
typedef float f32x4 __attribute__((ext_vector_type(4)));
typedef short bf16x8 __attribute__((ext_vector_type(8)));
typedef GAS unsigned gu32;
typedef GAS unsigned long long gu64;
#define RLX_AGENT __ATOMIC_RELAXED, __HIP_MEMORY_SCOPE_AGENT
#define LDS_WAIT() asm volatile("s_waitcnt lgkmcnt(0)" ::: "memory")
#define VM_WAIT() asm volatile("s_waitcnt vmcnt(0)" ::: "memory")
__device__ __forceinline__ unsigned long long rt() { return __builtin_amdgcn_s_memrealtime(); }
__device__ __forceinline__ unsigned f2bf(float f) { unsigned u = __builtin_bit_cast(unsigned, f); return (u + 0x7fffu + ((u >> 16) & 1u)) >> 16; }
__device__ __forceinline__ unsigned pk2(float lo, float hi) { return pg8::cvt_pk_bf16(lo, hi); }

#define XB_TMO      128
#define XB_XCNT(j)  (256  + 64 * (j))
#define XB_XSUB(j)  (1280 + 64 * (j))
#define XB_XGEN(j)  (2304 + 64 * (j))
#define XB_TOP      3328
#define XB_TOPGEN   3392
#define XCD_BAR_WORDS 3456
#define XB_SPIN_CAP (1u << 18)

__device__ __forceinline__ unsigned xb_ld(unsigned* p)              { return __hip_atomic_load(p, __ATOMIC_RELAXED, __HIP_MEMORY_SCOPE_AGENT); }
__device__ __forceinline__ unsigned xb_add(unsigned* p, unsigned v) { return __hip_atomic_fetch_add(p, v, __ATOMIC_RELAXED, __HIP_MEMORY_SCOPE_AGENT); }
__device__ __forceinline__ unsigned xb_xcc_id() { return (unsigned)__builtin_amdgcn_s_getreg((3 << 11) | 20) & 0xFu; }
#define XB_SPIN(cond, bar) do { unsigned _sp = 0; while (cond) { __builtin_amdgcn_s_sleep(1); \
    if ((++_sp & 255u) == 0u) { if (xb_ld(&(bar)[XB_TMO])) break; if (_sp > XB_SPIN_CAP) { atomicAdd(&(bar)[XB_TMO], 1u); break; } } } } while (0)

struct XcdBarrier {
    unsigned* bar; unsigned x;
    volatile LAS unsigned* st;
};

__device__ __forceinline__ XcdBarrier xcd_barrier_post(unsigned* bar, volatile LAS unsigned* st) {
    XcdBarrier b; b.bar = bar; b.x = xb_xcc_id(); b.st = st;
    if (threadIdx.x == 0) (void)xb_add(&bar[XB_XCNT(b.x)], 1u);
    return b;
}
__device__ __forceinline__ void xcd_barrier_complete(unsigned* bar, unsigned x, unsigned& nloc, unsigned& nx) {
    const unsigned G = gridDim.x * gridDim.y * gridDim.z;
    unsigned sum, cnt, mine, sp = 0u;
    for (;;) {
        sum = 0u; cnt = 0u; mine = 0u;
#pragma unroll
        for (unsigned j = 0; j < 16; ++j) { const unsigned c = xb_ld(&bar[XB_XCNT(j)]); sum += c; cnt += (c > 0u) ? 1u : 0u; mine = (j == x) ? c : mine; }
        if (sum == G) break;
        __builtin_amdgcn_s_sleep(1);
        if ((++sp & 255u) == 0u) { if (xb_ld(&bar[XB_TMO])) break; if (sp > XB_SPIN_CAP) { atomicAdd(&bar[XB_TMO], 1u); break; } }
    }
    nloc = mine > 0u ? mine : 1u; nx = cnt > 0u ? cnt : 1u;
}

__device__ __forceinline__ void xcd_barrier(const XcdBarrier& b) {
    asm volatile("s_waitcnt vmcnt(0)" ::: "memory");
    __syncthreads();
    if (threadIdx.x == 0) {
        unsigned* bar = b.bar;
        __builtin_amdgcn_s_waitcnt(0);
        unsigned nloc = b.st[0], nx = b.st[1];
        if (nloc == 0u) { xcd_barrier_complete(bar, b.x, nloc, nx); b.st[0] = nloc; b.st[1] = nx; }
        const unsigned old = xb_add(&bar[XB_XSUB(b.x)], 1u);
        const unsigned gen = old / nloc;
        if (old + 1u == (gen + 1u) * nloc) {
            __builtin_amdgcn_fence(__ATOMIC_RELEASE, "agent");
            asm volatile("s_waitcnt vmcnt(0)" ::: "memory");
            const unsigned og = xb_add(&bar[XB_TOP], 1u);
            const unsigned tg = og / nx;
            if (og + 1u == (tg + 1u) * nx) xb_add(&bar[XB_TOPGEN], 1u);
            else XB_SPIN(xb_ld(&bar[XB_TOPGEN]) == tg, bar);
            __builtin_amdgcn_fence(__ATOMIC_ACQUIRE, "agent");
            xb_add(&bar[XB_XGEN(b.x)], 1u);
            asm volatile("s_waitcnt vmcnt(0)" ::: "memory");
        } else {
            XB_SPIN(xb_ld(&bar[XB_XGEN(b.x)]) == gen, bar);
            __builtin_amdgcn_fence(__ATOMIC_ACQUIRE, "agent");
            asm volatile("s_waitcnt vmcnt(0)" ::: "memory");
        }
    }
    __syncthreads();
}

constexpr int DM = 2048, BATCH = 16, SEQ = 2048, DEPTH = 4, MTOK = BATCH * SEQ;
constexpr int INC = 11524;
constexpr int ZQ = 5376;
constexpr int GWD = 6144;
constexpr int N1 = ZQ + GWD;
constexpr int DFF = 8192;
constexpr int FB_COL = 3072;
constexpr float EPS = 1e-6f;
static_assert(ZQ == pg8::E_ZQ && GWD == pg8::E_GW && DM == pg8::E_DM && DFF == pg8::E_DFF, "shape constants");
constexpr int NWAVES = 8;

constexpr size_t MiB = 1u << 20;
constexpr size_t WS_CTL = 0, CTL_ZERO_BYTES = 96 * 1024;
constexpr size_t WS_WIN = 2 * MiB;
constexpr size_t WS_WUA = 47 * MiB;
constexpr size_t WS_WUB = 49 * MiB;
constexpr size_t WS_WUC = 51 * MiB;
constexpr size_t WS_WOUT = 54 * MiB;
constexpr size_t WS_WFI = 62 * MiB;
constexpr size_t WS_WFO = 94 * MiB;
constexpr size_t WS_LOGF = 126 * MiB;
constexpr size_t WS_SSQ = 127 * MiB;
constexpr size_t WS_H = 128 * MiB;
constexpr size_t WS_OA = 256 * MiB;
constexpr size_t WS_OB = 288 * MiB;
constexpr size_t WS_OC = 320 * MiB;
constexpr size_t WS_ASCR = 368 * MiB;
constexpr size_t WS_Z = 400 * MiB;
constexpr size_t WS_G = 736 * MiB;
constexpr size_t WS_U = WS_Z;
constexpr size_t WS_XB = 1120 * MiB;
constexpr size_t WS_H8 = 928 * MiB;
constexpr size_t WS_W8 = 992 * MiB;
constexpr size_t WS_RSC = 126 * MiB + 512 * 1024;
constexpr int CW_WMAX = 21000;
constexpr size_t WS_END = 1248 * MiB;
static_assert(WS_U + (size_t)MTOK * DFF * 2 <= WS_END && WS_G + (size_t)MTOK * GWD * 2 <= WS_END && WS_Z + (size_t)MTOK * ZQ * 2 <= WS_G && WS_WFO + 32 * MiB <= WS_LOGF, "d_ws map");
constexpr int CW_BAR = 4096;
constexpr int CW_QUEUE = 16384;

constexpr int RING_OFF = 0, RING_BYTES = 131072;
constexpr int EPI_OFF = RING_BYTES, EPI_BYTES = 8192;
constexpr int MISC_OFF = EPI_OFF + EPI_BYTES;
constexpr int LDS_BYTES = 147456;
static_assert(MISC_OFF + 1024 + 6 * 128 * 4 <= LDS_BYTES, "LDS map");

constexpr int NPH = 9;

struct Args { const float* in[23]; float* out; unsigned char* ws; int gp_lo, gp_hi; };
#define KIN(i) (F.args->in[i])
struct Frame {
    const Args* args;
    LAS unsigned char* lds;
    volatile LAS unsigned* MISC;
    gu32* ctl;
    int tid, lane, wave, vcu, G, bx;
    float* out;
    unsigned char* ws;
};

template <int X> __device__ __forceinline__ float swz_xor(float v) { return __int_as_float(__builtin_amdgcn_ds_swizzle(__float_as_int(v), (X << 10) | 0x1f)); }
__device__ __forceinline__ float half_sum(float v) { v += swz_xor<1>(v); v += swz_xor<2>(v); v += swz_xor<4>(v); v += swz_xor<8>(v); v += swz_xor<16>(v); return v; }
__device__ __forceinline__ float wave_sum(float v) {
    v = half_sum(v);
    auto rr = __builtin_amdgcn_permlane32_swap(__float_as_uint(v), __float_as_uint(v), false, false);
    return __uint_as_float(rr[0]) + __uint_as_float(rr[1]);
}
__device__ __forceinline__ float wave_max(float v) {
    v = fmaxf(v, swz_xor<1>(v)); v = fmaxf(v, swz_xor<2>(v)); v = fmaxf(v, swz_xor<4>(v)); v = fmaxf(v, swz_xor<8>(v)); v = fmaxf(v, swz_xor<16>(v));
    auto rr = __builtin_amdgcn_permlane32_swap(__float_as_uint(v), __float_as_uint(v), false, false);
    return fmaxf(__uint_as_float(rr[0]), __uint_as_float(rr[1]));
}
__device__ __forceinline__ float shfl_lane(float v, int srclane) { return __int_as_float(__builtin_amdgcn_ds_bpermute(srclane << 2, __float_as_int(v))); }
__device__ __forceinline__ float bflo(unsigned w) { return __uint_as_float(w << 16); }
__device__ __forceinline__ float bfhi(unsigned w) { return __uint_as_float(w & 0xffff0000u); }

__device__ __forceinline__ void transpose_item(const float* W, int ldw, int K  , bf16* WT, int n0s, int n0d, int k0, int kofs, LAS float* scr, int lane, const float* kgain) {
#pragma unroll 8
    for (int i = 0; i < 32; ++i) { const int kk = 2 * i + (lane >> 5); scr[kk * 33 + (lane & 31)] = ((const GAS float*)W)[(size_t)(k0 + kk) * ldw + n0s + (lane & 31)] * (kgain ? ((const GAS float*)kgain)[k0 + kk] : 1.0f); }
    LDS_WAIT(); asm volatile("" ::: "memory");
    const int c = lane & 7;
#pragma unroll
    for (int j = 0; j < 4; ++j) { const int n = (lane >> 3) + 8 * j; const LAS float* s = scr + (8 * c) * 33 + n;
        v4u o; o.x = pk2(s[0 * 33], s[1 * 33]); o.y = pk2(s[2 * 33], s[3 * 33]); o.z = pk2(s[4 * 33], s[5 * 33]); o.w = pk2(s[6 * 33], s[7 * 33]);
        *(GAS v4u*)((GAS bf16*)WT + (size_t)(n0d + n) * K + kofs + k0 + 8 * c) = o; }
    LDS_WAIT(); asm volatile("" ::: "memory");
}
typedef unsigned u32x2 __attribute__((ext_vector_type(2)));
__device__ __forceinline__ unsigned q8b(float v) { return (unsigned)((int)__builtin_rintf(v)) & 0xffu; }
__device__ __forceinline__ void transpose_item_i8(const float* W, int ldw, unsigned char* WT, int n0s, int n0d, int k0, LAS float* scr, int lane, float qs) {
#pragma unroll 8
    for (int i = 0; i < 32; ++i) { const int kk = 2 * i + (lane >> 5); scr[kk * 33 + (lane & 31)] = ((const GAS float*)W)[(size_t)(k0 + kk) * ldw + n0s + (lane & 31)] * qs; }
    LDS_WAIT(); asm volatile("" ::: "memory");
    const int c = lane & 7;
#pragma unroll
    for (int j = 0; j < 4; ++j) { const int n = (lane >> 3) + 8 * j; const LAS float* s = scr + (8 * c) * 33 + n;
        u32x2 o; o.x = q8b(s[0 * 33]) | (q8b(s[1 * 33]) << 8) | (q8b(s[2 * 33]) << 16) | (q8b(s[3 * 33]) << 24); o.y = q8b(s[4 * 33]) | (q8b(s[5 * 33]) << 8) | (q8b(s[6 * 33]) << 16) | (q8b(s[7 * 33]) << 24);
        *(GAS u32x2*)((GAS unsigned char*)WT + (size_t)(n0d + n) * DM + k0 + 8 * c) = o; }
    LDS_WAIT(); asm volatile("" ::: "memory");
}
__device__ __forceinline__ bool transpose_pick(int& r, const float* W, int ldw, int K, int Ndst, int skip_at, int skip, bf16* WT, LAS float* scr, int lane, int pitch = 0, int kofs = 0, const float* kgain = nullptr) {
    const int nblk = Ndst / 32, items = (K / 64) * nblk;
    if (r >= items) { r -= items; return false; }
    const int kb = r / nblk, nb = r % nblk, n0d = 32 * nb, n0s = n0d + (n0d >= skip_at ? skip : 0);
    transpose_item(W, ldw, pitch ? pitch : K, WT, n0s, n0d, 64 * kb, kofs, scr, lane, kgain);
    return true;
}
constexpr int W_NITEMS = (DM / 64) * (N1 / 32) + 2 * (512 / 64) * (DM / 32) + (768 / 64) * (DM / 32) + (DM / 64) * (DM / 32) + (DM / 64) * (DFF / 32) + (DFF / 64) * (DM / 32);
__device__ __forceinline__ void weights_item(Frame& F, int layer, int it, LAS float* scr, const float qs8w  ) {
    unsigned char* wb = F.ws;
    int r = it;
    { constexpr int nblk = (14 * 256) / 32, items = (DM / 64) * nblk;
      if (r < items) { const int kb = r / nblk, nb = r % nblk, c0 = 32 * nb, t = c0 >> 8, pn = t < 4 ? t : t < 8 ? t + 2 : t + 4, z0 = pn * 256 + (c0 & 255);
          transpose_item(KIN(2) + (size_t)layer * DM * INC, INC, DM, (bf16*)(wb + WS_WIN), z0 + (z0 >= FB_COL ? 4 : 0), c0, 64 * kb, 0, scr, F.lane, nullptr); return; }
      r -= items; }
    { constexpr int nblk = (7 * 256) / 32, items = (DM / 64) * nblk;
      if (r < items) { const int kb = r / nblk, nb = r % nblk, j0 = 32 * nb, z0 = j0 < 512 ? 1024 + j0 : j0 < 1024 ? 2560 + (j0 - 512) : 4608 + (j0 - 1024);
          transpose_item_i8(KIN(2) + (size_t)layer * DM * INC, INC, (unsigned char*)(wb + WS_W8), z0 + (z0 >= FB_COL ? 4 : 0), GWD + j0, 64 * kb, scr, F.lane, qs8w); return; }
      r -= items; }
    { constexpr int nblk = GWD / 32, items = (DM / 64) * nblk;
      if (r < items) { const int kb = r / nblk, nb = r % nblk;
          transpose_item_i8(KIN(2) + (size_t)layer * DM * INC, INC, (unsigned char*)(wb + WS_W8), ZQ + 4 + 32 * nb, 32 * nb, 64 * kb, scr, F.lane, qs8w); return; }
      r -= items; }
    if (transpose_pick(r, KIN(16) + (size_t)layer * 512 * DM, DM, 512, DM, 1 << 30, 0, (bf16*)(wb + WS_WUA), scr, F.lane, 1792, 0)) return;
    if (transpose_pick(r, KIN(17) + (size_t)layer * 512 * DM, DM, 512, DM, 1 << 30, 0, (bf16*)(wb + WS_WUA), scr, F.lane, 1792, 512)) return;
    if (transpose_pick(r, KIN(18) + (size_t)layer * 768 * DM, DM, 768, DM, 1 << 30, 0, (bf16*)(wb + WS_WUA), scr, F.lane, 1792, 1024)) return;
    if (transpose_pick(r, KIN(19) + (size_t)layer * DM * DM, DM, DM, DM, 1 << 30, 0, (bf16*)(wb + WS_WOUT), scr, F.lane)) return;
    if (transpose_pick(r, KIN(21) + (size_t)layer * DM * DFF, DFF, DM, DFF, 1 << 30, 0, (bf16*)(wb + WS_WFI), scr, F.lane, 0, 0, KIN(20) + (size_t)layer * DM)) return;
    transpose_pick(r, KIN(22) + (size_t)layer * DFF * DM, DM, DFF, DM, 1 << 30, 0, (bf16*)(wb + WS_WFO), scr, F.lane);
}
__device__ __forceinline__ void p_weights(Frame& F, int layer) {
    LAS float* scr = (LAS float*)(F.lds + RING_OFF + F.wave * 8448);
    const int gw = F.vcu * NWAVES + F.wave, NGW = F.G * NWAVES;
    const float qs8w = 127.0f / fmaxf(__uint_as_float(__hip_atomic_load(F.ctl + CW_WMAX + layer, __ATOMIC_RELAXED, __HIP_MEMORY_SCOPE_AGENT)), 1e-30f);
    for (int it = gw; it < W_NITEMS; it += NGW) weights_item(F, layer, it, scr, qs8w);
}
__device__ __forceinline__ void p_weights_dyn(Frame& F, int layer, gu32* ctr) {
    LAS float* scr = (LAS float*)(F.lds + RING_OFF + F.wave * 8448);
    constexpr int CH = 4;
    for (;;) {
        int base = 0; if (F.lane == 0) base = (int)__hip_atomic_fetch_add(ctr, (unsigned)CH, RLX_AGENT);
        base = __builtin_amdgcn_readfirstlane(base);
        if (base >= W_NITEMS) break;
        for (int j = 0; j < CH; ++j) if (base + j < W_NITEMS) weights_item(F, layer, base + j, scr, 0.f);
    }
}
__device__ __forceinline__ void wmax_scan(Frame& F, int layer, int rank, int nw) {
    const GAS float* wg = (const GAS float*)(KIN(2) + (size_t)layer * DM * INC); float mx = 0.f; constexpr int WCH = (INC + 63) / 64;
    const int r0 = __builtin_amdgcn_readfirstlane(rank); int ln = F.lane; asm volatile("" : "+v"(ln));
    for (int c = r0; c < DM * WCH; c += 16 * nw) {
        float t[16];
#pragma unroll
        for (int u = 0; u < 16; ++u) { const int cu = c + u * nw; const int cv = cu < DM * WCH ? cu : r0; const int kk = cv / WCH, cc = cv % WCH; const int col = 64 * cc + ln; t[u] = wg[(size_t)kk * INC + (col < INC ? col : 0)]; }
#pragma unroll
        for (int u = 0; u < 16; ++u) mx = fmaxf(mx, fabsf(t[u])); }
    mx = wave_max(mx);
    if (F.lane == 0) __hip_atomic_fetch_max(F.ctl + CW_WMAX + layer, __float_as_uint(mx), __ATOMIC_RELAXED, __HIP_MEMORY_SCOPE_AGENT);
}
template <bool FB, bool IN_F32>
__device__ __forceinline__ void p_norm(Frame& F, const float* X, const float* g, bf16* H, bf16* XB, const float* bfg, float* logf, const LAS float* wfb) {
    const int gw = F.vcu * NWAVES + F.wave, NGW = F.G * NWAVES, lane = F.lane;
    const GAS float* Xg = (const GAS float*)X; GAS bf16* xb = (GAS bf16*)XB; GAS bf16* Hg = (GAS bf16*)H; GAS float* logfg = (GAS float*)logf;
    f32x4 gv[4][2];
#pragma unroll
    for (int j = 0; j < 4; ++j) { gv[j][0] = *(const GAS f32x4*)((const GAS float*)g + 8 * lane + 512 * j); gv[j][1] = *(const GAS f32x4*)((const GAS float*)g + 8 * lane + 512 * j + 4); }
    for (int m = gw; m < MTOK; m += NGW) {
        f32x4 v[4][2]; float s = 0.f;
        if (IN_F32) {
#pragma unroll
            for (int j = 0; j < 4; ++j) { v[j][0] = *(const GAS f32x4*)(Xg + (size_t)m * DM + 8 * lane + 512 * j); v[j][1] = *(const GAS f32x4*)(Xg + (size_t)m * DM + 8 * lane + 512 * j + 4); }
#pragma unroll
            for (int j = 0; j < 4; ++j) { v4u o; o.x = pk2(v[j][0][0], v[j][0][1]); o.y = pk2(v[j][0][2], v[j][0][3]); o.z = pk2(v[j][1][0], v[j][1][1]); o.w = pk2(v[j][1][2], v[j][1][3]);
                *(GAS v4u*)(xb + (size_t)m * DM + 8 * lane + 512 * j) = o;
                v[j][0] = (f32x4){bflo(o.x), bfhi(o.x), bflo(o.y), bfhi(o.y)}; v[j][1] = (f32x4){bflo(o.z), bfhi(o.z), bflo(o.w), bfhi(o.w)}; }
        } else {
#pragma unroll
            for (int j = 0; j < 4; ++j) { const v4u w = *(const GAS v4u*)(xb + (size_t)m * DM + 8 * lane + 512 * j);
                v[j][0] = (f32x4){bflo(w.x), bfhi(w.x), bflo(w.y), bfhi(w.y)}; v[j][1] = (f32x4){bflo(w.z), bfhi(w.z), bflo(w.w), bfhi(w.w)}; }
        }
#pragma unroll
        for (int j = 0; j < 4; ++j)
#pragma unroll
            for (int q = 0; q < 2; ++q) s += (v[j][q][0] * v[j][q][0] + v[j][q][1] * v[j][q][1]) + (v[j][q][2] * v[j][q][2] + v[j][q][3] * v[j][q][3]);
        const float rstd = 1.0f / sqrtf(wave_sum(s) * (1.0f / DM) + EPS);
        float mraw = 0.f;
#pragma unroll
        for (int j = 0; j < 4; ++j)
#pragma unroll
            for (int q = 0; q < 2; ++q)
#pragma unroll
                for (int e = 0; e < 4; ++e) mraw = fmaxf(mraw, fabsf(v[j][q][e] * gv[j][q][e]));
        const float hmax = fmaxf(wave_max(mraw) * rstd, 1e-30f), qs8 = 127.0f / hmax;
        if (lane == 0) ((GAS float*)(F.ws + WS_RSC))[m] = hmax * (1.0f / 127.0f);
        float f0 = 0.f, f1 = 0.f, f2 = 0.f, f3 = 0.f;
#pragma unroll
        for (int j = 0; j < 4; ++j) { v[j][0] = v[j][0] * rstd * gv[j][0]; v[j][1] = v[j][1] * rstd * gv[j][1];
            if (FB) {
#pragma unroll
                for (int e = 0; e < 8; ++e) { const f32x4 w = *(const LAS f32x4*)(wfb + (size_t)(8 * lane + 512 * j + e) * 4); const float hv = v[j][e >> 2][e & 3]; f0 += hv * w[0]; f1 += hv * w[1]; f2 += hv * w[2]; f3 += hv * w[3]; }
            }
            v4u o; o.x = pk2(v[j][0][0], v[j][0][1]); o.y = pk2(v[j][0][2], v[j][0][3]); o.z = pk2(v[j][1][0], v[j][1][1]); o.w = pk2(v[j][1][2], v[j][1][3]);
            *(GAS v4u*)(Hg + (size_t)m * DM + 8 * lane + 512 * j) = o;
            { u32x2 q; q.x = q8b(v[j][0][0] * qs8) | (q8b(v[j][0][1] * qs8) << 8) | (q8b(v[j][0][2] * qs8) << 16) | (q8b(v[j][0][3] * qs8) << 24);
              q.y = q8b(v[j][1][0] * qs8) | (q8b(v[j][1][1] * qs8) << 8) | (q8b(v[j][1][2] * qs8) << 16) | (q8b(v[j][1][3] * qs8) << 24);
              *(GAS u32x2*)((GAS unsigned char*)(F.ws + WS_H8) + (size_t)m * DM + 8 * lane + 512 * j) = q; }
            if (FB) asm volatile("" ::: "memory"); }
        if (FB) {
            f0 = wave_sum(f0); f1 = wave_sum(f1); f2 = wave_sum(f2); f3 = wave_sum(f3);
            if (lane < 4) { float z = (lane == 0 ? f0 : lane == 1 ? f1 : lane == 2 ? f2 : f3) + ((const GAS float*)bfg)[lane];
                const float ls = fminf(z, 0.f) - log1pf(expf(-fabsf(z)));
                logfg[(size_t)m * 4 + lane] = ls; }
        }
    }
}
namespace att {
typedef short bf16x8 __attribute__((ext_vector_type(8)));
typedef short s16x4 __attribute__((ext_vector_type(4)));
typedef float f32x16 __attribute__((ext_vector_type(16)));
typedef float f32x4 __attribute__((ext_vector_type(4)));
typedef unsigned u32x4 __attribute__((ext_vector_type(4)));
constexpr int KVBLK = 64, QB = 256;
constexpr int SHM_V = KVBLK * 128 * 2, SHM_K = KVBLK * 128 * 2;
constexpr int L_V = 0, L_K = 2 * SHM_V, L_WS = 2 * SHM_V + 2 * SHM_K, L_TBL = L_WS + 8 * 256;
constexpr int TBL_N = 2176;
constexpr int ATT_LDS = L_TBL + TBL_N * 4;
#define KSWZ(row, colB) ((row) * 256 + ((colB) ^ (((row) & 15) << 4)))
#define SBAR() __builtin_amdgcn_sched_barrier(0)
__device__ __forceinline__ int v_st(int k, int c) { const int kk = (k & ~0xC) | ((k & 4) << 1) | ((k & 8) >> 1); return ((kk >> 3) * 4 + (c >> 5)) * 512 + ((kk & 7) * 32 + (c & 31)) * 2; }
__device__ __forceinline__ int v_rd_base(int lane) { return ((lane & 3) << 3) | (((lane >> 2) & 3) << 6) | (((lane >> 4) & 1) << 5) | (((lane >> 5) & 1) << 8); }
constexpr int v_rd_off(int d0, int ks, int half) { return d0 * 512 + ks * 4096 + half * 2048; }
__device__ __forceinline__ int crow(int r, int hi) { return (r & 3) + 8 * (r >> 2) + 4 * hi; }
__device__ __forceinline__ unsigned cvtpk(float lo, float hi) { return pg8::cvt_pk_bf16(lo, hi); }

template <int KB, int NQ>
__device__ __forceinline__ void qkt(f32x16& p0, f32x16& p1, const LAS char* K_lds, int r32, int hi, const bf16x8* qr) {
    const LAS char* kb[NQ];
#pragma unroll
    for (int dd = 0; dd < NQ; ++dd) kb[dd] = K_lds + KB * SHM_K + KSWZ(r32, (dd * 16 + hi * 8) * 2);
#pragma unroll
    for (int d0 = 0; d0 < NQ; ++d0) { const LAS char* a = kb[d0];
        bf16x8 b0 = *(const LAS bf16x8*)(a);
        bf16x8 b1 = *(const LAS bf16x8*)(a + 32 * 256);
        p0 = __builtin_amdgcn_mfma_f32_32x32x16_bf16(b0, qr[d0], p0, 0, 0, 0);
        p1 = __builtin_amdgcn_mfma_f32_32x32x16_bf16(b1, qr[d0], p1, 0, 0, 0); }
}
template <int VB>
__device__ __forceinline__ void pv_tile(f32x16* o, int vb0, bf16x8 pa0, bf16x8 pa1, bf16x8 pa2, bf16x8 pa3) {
    s16x4 xl0, xl1, xl2, xl3, xh0, xh1, xh2, xh3, yl0, yl1, yl2, yl3, yh0, yh1, yh2, yh3;
#define TRRD(dst, off) asm volatile("ds_read_b64_tr_b16 %0, %1 offset:%2" : "=&v"(dst) : "v"(vb0), "i"(off) : "memory")
#define PV_RD(d0, S) do { constexpr int b_ = VB * SHM_V + v_rd_off(d0, 0, 0); \
        TRRD(S##l0, b_); TRRD(S##h0, b_ + 2048); TRRD(S##l1, b_ + 4096); TRRD(S##h1, b_ + 6144); TRRD(S##l2, b_ + 8192); TRRD(S##h2, b_ + 10240); TRRD(S##l3, b_ + 12288); TRRD(S##h3, b_ + 14336); } while (0)
#define PV_MM(d0, S) do { \
        o[d0] = __builtin_amdgcn_mfma_f32_32x32x16_bf16((bf16x8){S##l0[0], S##l0[1], S##l0[2], S##l0[3], S##h0[0], S##h0[1], S##h0[2], S##h0[3]}, pa0, o[d0], 0, 0, 0); \
        o[d0] = __builtin_amdgcn_mfma_f32_32x32x16_bf16((bf16x8){S##l1[0], S##l1[1], S##l1[2], S##l1[3], S##h1[0], S##h1[1], S##h1[2], S##h1[3]}, pa1, o[d0], 0, 0, 0); \
        o[d0] = __builtin_amdgcn_mfma_f32_32x32x16_bf16((bf16x8){S##l2[0], S##l2[1], S##l2[2], S##l2[3], S##h2[0], S##h2[1], S##h2[2], S##h2[3]}, pa2, o[d0], 0, 0, 0); \
        o[d0] = __builtin_amdgcn_mfma_f32_32x32x16_bf16((bf16x8){S##l3[0], S##l3[1], S##l3[2], S##l3[3], S##h3[0], S##h3[1], S##h3[2], S##h3[3]}, pa3, o[d0], 0, 0, 0); SBAR(); } while (0)
#define PV_WAIT(n) do { asm volatile("s_waitcnt lgkmcnt(" #n ")" ::: "memory"); SBAR(); } while (0)
    PV_RD(0, x); PV_RD(1, y);
    PV_WAIT(8); PV_MM(0, x); PV_RD(2, x);
    PV_WAIT(8); PV_MM(1, y); PV_RD(3, y);
    PV_WAIT(8); PV_MM(2, x);
    PV_WAIT(0); PV_MM(3, y);
#undef PV_WAIT
#undef PV_MM
#undef PV_RD
#undef TRRD
}
__device__ __forceinline__ void softmax_tile(f32x16& p0, f32x16& p1, float& m_reg, float& l_reg, float& alpha, bf16x8& pa0, bf16x8& pa1, bf16x8& pa2, bf16x8& pa3) {
    float pmax = p0[0];
#pragma unroll
    for (int r = 1; r < 16; ++r) pmax = fmaxf(pmax, p0[r]);
#pragma unroll
    for (int r = 0; r < 16; ++r) pmax = fmaxf(pmax, p1[r]);
    { auto rr = __builtin_amdgcn_permlane32_swap(__float_as_uint(pmax), __float_as_uint(pmax), false, false);
      pmax = fmaxf(__uint_as_float(rr[0]), __uint_as_float(rr[1])); }
    const float mn = fmaxf(m_reg, pmax);
    alpha = __builtin_amdgcn_exp2f(m_reg - mn); m_reg = mn;
    float ps = 0.f;
#pragma unroll
    for (int r = 0; r < 16; ++r) { p0[r] = __builtin_amdgcn_exp2f(p0[r] - mn); ps += p0[r]; }
#pragma unroll
    for (int r = 0; r < 16; ++r) { p1[r] = __builtin_amdgcn_exp2f(p1[r] - mn); ps += p1[r]; }
    { auto rr = __builtin_amdgcn_permlane32_swap(__float_as_uint(ps), __float_as_uint(ps), false, false);
      ps = __uint_as_float(rr[0]) + __uint_as_float(rr[1]); }
    l_reg = l_reg * alpha + ps;
#define PK4(P, B_, OUT) do { unsigned a0 = cvtpk(P[B_+0], P[B_+1]), a1 = cvtpk(P[B_+2], P[B_+3]); \
        unsigned b0 = cvtpk(P[B_+4], P[B_+5]), b1 = cvtpk(P[B_+6], P[B_+7]); \
        auto r0 = __builtin_amdgcn_permlane32_swap(a0, b0, false, false); auto r1 = __builtin_amdgcn_permlane32_swap(a1, b1, false, false); \
        u32x4 w = {r0[0], r1[0], r0[1], r1[1]}; OUT = *reinterpret_cast<bf16x8*>(&w); } while (0)
    PK4(p0, 0, pa0); PK4(p0, 8, pa1); PK4(p1, 0, pa2); PK4(p1, 8, pa3);
#undef PK4
}

__device__ __forceinline__ void softmax_nomax(f32x16& p0, f32x16& p1, float& l_reg, bf16x8& pa0, bf16x8& pa1, bf16x8& pa2, bf16x8& pa3) {
    float ps = 0.f;
#pragma unroll
    for (int r = 0; r < 16; ++r) { p0[r] = __builtin_amdgcn_exp2f(p0[r]); ps += p0[r]; }
#pragma unroll
    for (int r = 0; r < 16; ++r) { p1[r] = __builtin_amdgcn_exp2f(p1[r]); ps += p1[r]; }
    { auto rr = __builtin_amdgcn_permlane32_swap(__float_as_uint(ps), __float_as_uint(ps), false, false);
      ps = __uint_as_float(rr[0]) + __uint_as_float(rr[1]); }
    l_reg += ps;
#define PK4(P, B_, OUT) do { unsigned a0 = cvtpk(P[B_+0], P[B_+1]), a1 = cvtpk(P[B_+2], P[B_+3]); \
        unsigned b0 = cvtpk(P[B_+4], P[B_+5]), b1 = cvtpk(P[B_+6], P[B_+7]); \
        auto r0 = __builtin_amdgcn_permlane32_swap(a0, b0, false, false); auto r1 = __builtin_amdgcn_permlane32_swap(a1, b1, false, false); \
        u32x4 w = {r0[0], r1[0], r0[1], r1[1]}; OUT = *reinterpret_cast<bf16x8*>(&w); } while (0)
    PK4(p0, 0, pa0); PK4(p0, 8, pa1); PK4(p1, 0, pa2); PK4(p1, 8, pa3);
#undef PK4
}

enum { KIND_A = 0, KIND_B = 1, KIND_C = 2 };
struct UnitDesc { int kind, h, b, qb; };
constexpr int NUNITS = 8 * BATCH * 14;
__device__ __forceinline__ UnitDesc decode_unit(int u) {
    UnitDesc d; d.qb = 7 - u / (BATCH * 14); const int r = u % (BATCH * 14); const int hk = r / BATCH; d.b = r % BATCH;
    if (hk < 4) { d.kind = KIND_A; d.h = hk; } else if (hk < 10) { d.kind = KIND_C; d.h = hk - 4; } else { d.kind = KIND_B; d.h = hk - 10; }
    return d;
}

struct NoTable { __device__ __forceinline__ void operator()() const {} };
template <int KIND, int DQK, class TB>
__device__ __forceinline__ void attn_pass(const GAS bf16* Qp, const GAS bf16* Kp, const GAS bf16* Vp, int Q0, LAS char* lds, int tid, f32x16 (&o)[4], float& l_out, const float C2, const TB& build_table, const float slope2 = 0.f  ) {
    constexpr int NQ = DQK / 16;
    const int wid = __builtin_amdgcn_readfirstlane(tid >> 6), lane = tid & 63, r32 = lane & 31, hi = lane >> 5;
    LAS char* V_lds = lds + L_V; LAS char* K_lds = lds + L_K;
    const LAS float* tbl = (const LAS float*)(lds + L_TBL);
    const int qlo = Q0 + wid * 32, qpos = qlo + r32;
    bf16x8 qr[NQ];
#pragma unroll
    for (int d0 = 0; d0 < NQ; ++d0) qr[d0] = *(const GAS bf16x8*)(Qp + (size_t)qpos * ZQ + d0 * 16 + hi * 8);
    const int sr = tid >> 4, sc = (tid & 15) * 8;
    const int vst0 = v_st(sr, sc), vst1 = v_st(32 + sr, sc);
    const int kws = KSWZ(sr, sc * 2);
    const int kr64 = tid >> 3, kc64 = (tid & 7) * 8, kws64 = KSWZ(kr64, kc64 * 2);
    const int vb0 = (int)(unsigned)(uintptr_t)V_lds + v_rd_base(lane);
    bf16x8 st_v0, st_v1, st_k0, st_k1;
#define SLOAD(k0) do { st_v0 = *(const GAS bf16x8*)(Vp + (size_t)((k0) + sr) * ZQ + sc); st_v1 = *(const GAS bf16x8*)(Vp + (size_t)((k0) + 32 + sr) * ZQ + sc); \
        if (DQK == 128) { st_k0 = *(const GAS bf16x8*)(Kp + (size_t)((k0) + sr) * ZQ + sc); st_k1 = *(const GAS bf16x8*)(Kp + (size_t)((k0) + 32 + sr) * ZQ + sc); } \
        else { st_k0 = *(const GAS bf16x8*)(Kp + (size_t)((k0) + kr64) * ZQ + kc64); } } while (0)
#define SWRITE(bf) do { *(LAS bf16x8*)(V_lds + (bf) * SHM_V + vst0) = st_v0; *(LAS bf16x8*)(V_lds + (bf) * SHM_V + vst1) = st_v1; \
        if (DQK == 128) { *(LAS bf16x8*)(K_lds + (bf) * SHM_K + kws) = st_k0; *(LAS bf16x8*)(K_lds + (bf) * SHM_K + kws + 32 * 256) = st_k1; } \
        else { *(LAS bf16x8*)(K_lds + (bf) * SHM_K + kws64) = st_k0; } } while (0)
    float l_reg = 0.f;
#pragma unroll
    for (int d = 0; d < 4; ++d) o[d] = f32x16{};
    const int tmax = Q0 / KVBLK + 3;
    SLOAD(tmax * KVBLK); build_table(); asm volatile("s_waitcnt vmcnt(0)" ::: "memory"); SWRITE(0);
    __syncthreads();
    float cq = 0.f; if (KIND == KIND_B) cq = -tbl[qpos];
    int tl = 0;
    if (KIND == KIND_B) {
        const bool need = (lane > tmax) || (tbl[64 * (lane < 32 ? lane : 0) + 63] - tbl[Q0] >= -172.0f) || lane >= 32;
        const unsigned long long mk = __ballot(need);
        tl = (__ffsll((long long)mk) - 1) & ~1;
    } else {
        const int kmin = Q0 - (int)(174.0f / slope2);
        tl = kmin > 0 ? ((kmin >> 6) & ~1) : 0;
    }
    tl = __builtin_amdgcn_readfirstlane(tl);
#define TILE_STEP(BUF, t_) do { const int kb_ = (t_) * KVBLK; \
        if ((t_) > tl) SLOAD(kb_ - KVBLK); \
        if (kb_ <= qlo + 31) {                                    \
            f32x16 p0, p1; bf16x8 pa0, pa1, pa2, pa3; \
            if (KIND == KIND_B) {                                 \
                const LAS f32x4* tb = (const LAS f32x4*)(tbl + kb_ + 4 * hi); \
                _Pragma("unroll") for (int g = 0; g < 4; ++g) { const f32x4 b0 = tb[2 * g], b1 = tb[2 * g + 8]; \
                    _Pragma("unroll") for (int j = 0; j < 4; ++j) { p0[4 * g + j] = b0[j] + cq; p1[4 * g + j] = b1[j] + cq; } }     \
            } else {                                              \
                const LAS float* tb = tbl + (2047 - (qpos - kb_ - 4 * hi)); \
                _Pragma("unroll") for (int r = 0; r < 16; ++r) { const int c = (r & 3) + 8 * (r >> 2); p0[r] = tb[c]; p1[r] = tb[c + 32]; } \
            } \
            qkt<BUF, NQ>(p0, p1, K_lds, r32, hi, qr); \
            if (KIND == KIND_B && kb_ + KVBLK - 1 > qlo) {        \
                const int dq = qpos - kb_ - 4 * hi; const float NEG = -__builtin_inff(); \
                _Pragma("unroll") for (int r = 0; r < 16; ++r) { const int c = (r & 3) + 8 * (r >> 2); if (dq - c < 0) p0[r] = NEG; if (dq - c - 32 < 0) p1[r] = NEG; } } \
            softmax_nomax(p0, p1, l_reg, pa0, pa1, pa2, pa3); \
            SBAR(); pv_tile<BUF>(o, vb0, pa0, pa1, pa2, pa3); \
        } \
        if ((t_) > tl) { asm volatile("s_waitcnt vmcnt(0)" ::: "memory"); SWRITE((BUF) ^ 1); } \
        __syncthreads(); } while (0)
    int t = tmax;
    for (; t >= tl + 1; t -= 2) { TILE_STEP(0, t); TILE_STEP(1, t - 1); }
#undef TILE_STEP
#undef SLOAD
#undef SWRITE
    l_out = l_reg;
}

__device__ __forceinline__ void store_o_rows(GAS bf16* Orow  , int hi, const f32x16 (&v)[4]) {
    GAS char* p = (GAS char*)Orow + (hi ? 16 : 0);
#pragma unroll
    for (int d0 = 0; d0 < 4; ++d0)
#pragma unroll
        for (int g = 0; g < 4; g += 2) {
            unsigned ax = cvtpk(v[d0][4 * g], v[d0][4 * g + 1]), ay = cvtpk(v[d0][4 * g + 2], v[d0][4 * g + 3]);
            unsigned bx = cvtpk(v[d0][4 * g + 4], v[d0][4 * g + 5]), by = cvtpk(v[d0][4 * g + 6], v[d0][4 * g + 7]);
            auto rx = __builtin_amdgcn_permlane32_swap(ax, bx, false, false); auto ry = __builtin_amdgcn_permlane32_swap(ay, by, false, false);
            *(GAS u32x4*)(p + 16 * (4 * d0 + g)) = (u32x4){rx[0], ry[0], rx[1], ry[1]}; }
}
}

__device__ __forceinline__ void attn_unit_B(Frame& F, const att::UnitDesc d, int tid) {
    using namespace att;
    asm volatile("" : "+v"(tid));
    LAS char* lds = (LAS char*)F.lds + RING_OFF;
    const int wid = __builtin_amdgcn_readfirstlane(tid >> 6), lane = tid & 63, r32 = lane & 31, hi = lane >> 5;
    LAS float* tbl = (LAS float*)(lds + L_TBL);
    const GAS bf16* Z = (const GAS bf16*)(F.ws + WS_Z);
    const int Q0 = d.qb * QB; const size_t seq0 = (size_t)d.b * SEQ; const float LOG2E = 1.4426950408889634f;
    f32x16 o[4]; float l_reg;
    auto build = [&]() {
    { const GAS float* lf = (const GAS float*)(F.ws + WS_LOGF); const int n = Q0 + QB, p0 = 4 * tid;
      float v0 = 0.f, v1 = 0.f, v2 = 0.f, v3 = 0.f;
      if (p0 < n) { v0 = lf[(seq0 + p0) * 4 + d.h]; v1 = lf[(seq0 + p0 + 1) * 4 + d.h]; v2 = lf[(seq0 + p0 + 2) * 4 + d.h]; v3 = lf[(seq0 + p0 + 3) * 4 + d.h]; }
      v1 += v0; v2 += v1; v3 += v2;
      float sc = v3;
#pragma unroll
      for (int o = 1; o < 64; o <<= 1) { const float t = shfl_lane(sc, (lane - o) & 63); if (lane >= o) sc += t; }
      if (lane == 63) tbl[2100 + wid] = sc;
      __syncthreads();
      float off = sc - v3;
#pragma unroll
      for (int w = 0; w < NWAVES; ++w) off += (w < wid) ? tbl[2100 + w] : 0.f;
      if (p0 < n) *(LAS f32x4*)(tbl + p0) = (f32x4){-LOG2E * (v0 + off), -LOG2E * (v1 + off), -LOG2E * (v2 + off), -LOG2E * (v3 + off)}; }
    };
    const GAS bf16* base = Z + seq0 * ZQ;
    attn_pass<KIND_B, 128>(base + 1536 + d.h * 128, base + 2048 + d.h * 128, base + 2560 + d.h * 128, Q0, lds, tid, o, l_reg, 0.08838834764831845f * LOG2E, build);
    { const float il = 1.0f / l_reg;
#pragma unroll
      for (int d0 = 0; d0 < 4; ++d0) o[d0] *= il; }
    store_o_rows((GAS bf16*)(F.ws + WS_OA) + (seq0 + Q0 + wid * 32 + r32) * 1792 + 512 + d.h * 128, hi, o);
}
__device__ __forceinline__ void attn_unit_C(Frame& F, const att::UnitDesc d, int tid) {
    using namespace att;
    asm volatile("" : "+v"(tid));
    LAS char* lds = (LAS char*)F.lds + RING_OFF;
    const int wid = __builtin_amdgcn_readfirstlane(tid >> 6), lane = tid & 63, r32 = lane & 31, hi = lane >> 5;
    LAS float* tbl = (LAS float*)(lds + L_TBL);
    const GAS bf16* Z = (const GAS bf16*)(F.ws + WS_Z);
    const int Q0 = d.qb * QB; const size_t seq0 = (size_t)d.b * SEQ; const float LOG2E = 1.4426950408889634f;
    f32x16 o[4]; float l_reg;
    const float slope2 = exp2f(-8.0f * (float)(d.h + 1) / 6.0f) * LOG2E;
    auto build = [&]() {
    for (int i = tid; i < TBL_N; i += NWAVES * 64) { const int D = 2047 - i; float v;
        if (D < 0) v = -__builtin_inff();
        else { const int cnt = (D <= 128 ? 1 : 0) + (((D & 3) == 0 && D <= 512) ? 1 : 0) + (((D & 15) == 0) ? 1 : 0);
               v = cnt == 0 ? -__builtin_inff() : (-slope2 * (float)D + (cnt == 1 ? 0.f : cnt == 2 ? 1.0f : 1.5849625007211562f)); }
        tbl[i] = v; }
    };
    const GAS bf16* base = Z + seq0 * ZQ;
    attn_pass<KIND_C, 128>(base + 3072 + d.h * 128, base + 3840 + d.h * 128, base + 4608 + d.h * 128, Q0, lds, tid, o, l_reg, 0.08838834764831845f * LOG2E, build, slope2);
    { const float il = 1.0f / l_reg;
#pragma unroll
      for (int d0 = 0; d0 < 4; ++d0) o[d0] *= il; }
    store_o_rows((GAS bf16*)(F.ws + WS_OA) + (seq0 + Q0 + wid * 32 + r32) * 1792 + 1024 + d.h * 128, hi, o);
}
__device__ __forceinline__ void attn_unit_A(Frame& F, const att::UnitDesc d, int tid, int layer, const float lam, const float lam_init) {
    using namespace att;
    asm volatile("" : "+v"(tid));
    LAS char* lds = (LAS char*)F.lds + RING_OFF;
    const int wid = __builtin_amdgcn_readfirstlane(tid >> 6), lane = tid & 63, r32 = lane & 31, hi = lane >> 5;
    LAS float* tbl = (LAS float*)(lds + L_TBL);
    const GAS bf16* Z = (const GAS bf16*)(F.ws + WS_Z);
    const GAS char* scrb = (const GAS char*)(F.ws + WS_ASCR + (size_t)F.bx * 131072 + (size_t)wid * 16384);
    const unsigned scrl = (unsigned)lane * 16u;
    const GAS float* gsub = (const GAS float*)KIN(11) + layer * 128;
    const int Q0 = d.qb * QB; const size_t seq0 = (size_t)d.b * SEQ; const float LOG2E = 1.4426950408889634f;
    f32x16 o[4]; float l_reg;
    const float slope2 = exp2f(-2.0f * (float)(d.h + 1)) * LOG2E;
    auto build = [&]() { for (int i = tid; i < TBL_N; i += NWAVES * 64) { const int D = 2047 - i; tbl[i] = D < 0 ? -__builtin_inff() : -slope2 * (float)D; } };
    const GAS bf16* base = Z + seq0 * ZQ;
    attn_pass<KIND_A, 64>(base + d.h * 128, base + 512 + d.h * 128, base + 1024 + d.h * 128, Q0, lds, tid, o, l_reg, 0.125f * LOG2E, build, slope2);
    { const float il = 1.0f / l_reg;
#pragma unroll
      for (int d0 = 0; d0 < 4; ++d0)
#pragma unroll
          for (int g = 0; g < 4; ++g) *(GAS f32x4*)(scrb + (size_t)((4 * d0 + g) * 64) * 16 + scrl) = (f32x4){o[d0][4 * g] * il, o[d0][4 * g + 1] * il, o[d0][4 * g + 2] * il, o[d0][4 * g + 3] * il}; }
    asm volatile("" ::: "memory");
    attn_pass<KIND_A, 64>(base + d.h * 128 + 64, base + 512 + d.h * 128 + 64, base + 1024 + d.h * 128, Q0, lds, tid, o, l_reg, 0.125f * LOG2E, NoTable(), slope2);
    { const float il = lam / l_reg; float ssq = 0.f;
#pragma unroll
      for (int d0 = 0; d0 < 4; ++d0)
#pragma unroll
          for (int g = 0; g < 4; ++g) { const f32x4 o0 = *(const GAS f32x4*)(scrb + (size_t)((4 * d0 + g) * 64) * 16 + scrl);
#pragma unroll
              for (int j = 0; j < 4; ++j) { const float v = o0[j] - o[d0][4 * g + j] * il; o[d0][4 * g + j] = v; ssq += v * v; } }
      { auto rr = __builtin_amdgcn_permlane32_swap(__float_as_uint(ssq), __float_as_uint(ssq), false, false); ssq = __uint_as_float(rr[0]) + __uint_as_float(rr[1]); }
      const float rs = (1.0f / sqrtf(ssq * (1.0f / 128.0f) + EPS)) * (1.0f - lam_init);
#pragma unroll
      for (int d0 = 0; d0 < 4; ++d0)
#pragma unroll
          for (int g = 0; g < 4; ++g) { const f32x4 gv = *(const GAS f32x4*)(gsub + 32 * d0 + 8 * g + 4 * hi);
#pragma unroll
              for (int j = 0; j < 4; ++j) o[d0][4 * g + j] *= rs * gv[j]; } }
    store_o_rows((GAS bf16*)(F.ws + WS_OA) + (seq0 + Q0 + wid * 32 + r32) * 1792 + d.h * 128, hi, o);
}
__device__ __forceinline__ void p_attn(Frame& F, int layer, int qword) {
    using namespace att;
    const int lane = F.lane;
    gu32* queue = F.ctl + CW_QUEUE + 64 * layer + qword;
    const float lam_init = 0.8f - 0.6f * expf(-0.3f * (float)layer);
    const float lam = expf(wave_sum(((const GAS float*)KIN(7))[layer * 64 + lane] * ((const GAS float*)KIN(8))[layer * 64 + lane]))
                    - expf(wave_sum(((const GAS float*)KIN(9))[layer * 64 + lane] * ((const GAS float*)KIN(10))[layer * 64 + lane])) + lam_init;
    if (F.tid == 0) F.MISC[4] = __hip_atomic_fetch_add(queue, 1u, RLX_AGENT);
    __syncthreads();
    int u = (int)F.MISC[4];
    while (u < NUNITS) {
        unsigned nxt = 0u; if (F.tid == 0) nxt = __hip_atomic_fetch_add(queue, 1u, RLX_AGENT);
        const UnitDesc d = decode_unit(u);
        if (d.kind == KIND_B) attn_unit_B(F, d, F.tid);
        else if (d.kind == KIND_C) attn_unit_C(F, d, F.tid);
        else attn_unit_A(F, d, F.tid, layer, lam, lam_init);
        if (F.tid == 0) F.MISC[4] = nxt;
        __syncthreads();
        u = (int)F.MISC[4];
    }
}
#ifndef WGM_P1
#define WGM_P1 4
#define WGM_P4 4
#define WGM_P5 4
#define WGM_P7 4
#define WGM_P8 4
#endif
#ifndef MK_PER_PHASE
#define MK_PER_PHASE 0
#endif
__global__ void __launch_bounds__(NWAVES * 64, 2) mk_fwd(Args args) {
    extern __shared__ __attribute__((aligned(16))) unsigned char lds[];
    Frame F;
    F.lds = (LAS unsigned char*)lds;
    F.MISC = (volatile LAS unsigned*)(F.lds + MISC_OFF);
    F.tid = threadIdx.x; F.lane = F.tid & 63; F.wave = __builtin_amdgcn_readfirstlane(F.tid >> 6);
    F.G = gridDim.x; F.bx = blockIdx.x; F.vcu = (F.bx % 8) * (F.G / 8) + F.bx / 8;
    F.ws = args.ws; F.out = args.out; F.ctl = (gu32*)(args.ws + WS_CTL);
    F.args = &args;
    if (F.tid < 64) ((LAS unsigned*)(F.lds + MISC_OFF))[F.tid] = 0u;
    __syncthreads();
    XcdBarrier bar; bar.bar = (unsigned*)(F.ctl + CW_BAR); bar.x = 0; bar.st = nullptr;
    if (!MK_PER_PHASE) bar = xcd_barrier_post((unsigned*)(F.ctl + CW_BAR), F.MISC + 8);
    const int lo = args.gp_lo, hi = args.gp_hi;
#define IN(k) (lo <= (k) && (k) < hi)
#define PH_ENTER() do { asm volatile("" : "+v"(F.tid), "+s"(F.bx), "+s"(F.ws), "+s"(F.out)); F.lane = F.tid & 63; F.wave = __builtin_amdgcn_readfirstlane(F.tid >> 6); \
    F.vcu = (F.bx % 8) * (F.G / 8) + F.bx / 8; } while (0)
#define SEAM(k) do { if ((k) + 1 < hi) { if (MK_PER_PHASE) { if (F.tid == 0) __hip_atomic_store(F.ctl + 0, 0xBADBA0u, RLX_AGENT); } else xcd_barrier(bar); } } while (0)

#define Hb ((bf16*)(F.ws + WS_H))
#define XBp ((bf16*)(F.ws + WS_XB))
    for (int layer = 0; layer < DEPTH; ++layer) {
        const int gp = layer * NPH; constexpr size_t WOFF = 0;
        if (IN(gp + 0)) { PH_ENTER();
            LAS float* wfb = (LAS float*)(F.lds + 98304);
            { const float* w_in = KIN(2) + (size_t)layer * DM * INC;
              for (int k = F.tid; k < DM; k += NWAVES * 64) *(LAS f32x4*)(wfb + 4 * k) = *(const GAS f32x4*)((const GAS float*)w_in + (size_t)k * INC + FB_COL); }
            if (layer == 0) { wmax_scan(F, 0, F.bx * NWAVES + F.wave, F.G * NWAVES);
              __syncthreads(); if (!MK_PER_PHASE) xcd_barrier(bar); PH_ENTER(); }
            p_weights(F, layer);
            __syncthreads();
            const float* g = KIN(1) + layer * DM; const float* bfg = KIN(3) + layer * 4; float* logf = (float*)(F.ws + WS_LOGF);
            if (layer == 0) p_norm<true, true>(F, KIN(0), g, Hb, XBp, bfg, logf, wfb);
            else p_norm<true, false>(F, nullptr, g, Hb, XBp, bfg, logf, wfb);
            __syncthreads();
            SEAM(gp + 0);
        }
        if (IN(gp + 1)) { PH_ENTER();
            pg8::Gemm g{Hb, (const bf16*)(F.ws + WOFF + WS_WIN), MTOK, 14 * 256, DM, DM}; pg8::StaticOrder S; S.init(MTOK, 14 * 256, F.G, F.bx, WGM_P1);
            LAS float* gl = (LAS float*)(F.lds + MISC_OFF + 1024);
            for (int i = F.tid; i < 768; i += NWAVES * 64) { const int kd = i >> 7, e = i & 127; const GAS float* src = (const GAS float*)(kd == 0 ? KIN(5) : kd == 1 ? KIN(6) : kd == 2 ? KIN(12) : kd == 3 ? KIN(13) : kd == 4 ? KIN(14) : KIN(15));
                gl[i] = (kd < 2 ? src[layer * 64 + (e & 63)] : src[layer * 128 + e]) * (kd == 0 ? 0.125f * 1.4426950408889634f : (kd == 2 || kd == 4) ? 0.08838834764831845f * 1.4426950408889634f : 1.0f); }
            __syncthreads();
            { pg8::Gemm g8{(const bf16*)(F.ws + WS_H8), (const bf16*)(F.ws + WOFF + WS_W8), MTOK, GWD + 7 * 256, DM / 2, DM / 2}; pg8::StaticOrder S8; S8.init(MTOK, GWD + 7 * 256, F.G, F.bx, 8);
              { const int zn = (MTOK / 256) * 14, zc0 = zn - ((zn + F.G - 1) / F.G - 1) * F.G; if (zc0 > 0 && zc0 < F.G) { S8.bal_rounds = S8.nwg / F.G - 1; S8.bal_from = zc0; } }
              const float wsc8 = __uint_as_float(__hip_atomic_load(F.ctl + CW_WMAX + layer, __ATOMIC_RELAXED, __HIP_MEMORY_SCOPE_AGENT)) * (-1.4426950408889634f / 127.0f);
              pg8::EpiG8 E8{(bf16*)(F.ws + WS_G), KIN(4) + (size_t)layer * GWD, (const float*)(F.ws + WS_RSC), wsc8, (bf16*)(F.ws + WS_Z), wsc8 * (-1.0f / 1.4426950408889634f)};
              pg8::gemm_phase<pg8::EpiG8, pg8::StaticOrder, true, true>(F.lds + RING_OFF, g8, S8, E8, F.tid);
              { const int c0 = S8.nwg - (S8.nwg / F.G) * F.G; PH_ENTER();
                if (layer + 1 < DEPTH && c0 > 0 && F.bx >= c0) wmax_scan(F, layer + 1, (F.bx - c0) * NWAVES + F.wave, (F.G - c0) * NWAVES); } }
            PH_ENTER();
            pg8::EpiZ E{(bf16*)(F.ws + WS_Z), (bf16*)(F.ws + WS_G), KIN(4) + (size_t)layer * GWD, (LAS float*)(F.lds + EPI_OFF), gl};
            pg8::gemm_phase<pg8::EpiZ, pg8::StaticOrder, true, true>(F.lds + RING_OFF, g, S, E, F.tid);
            SEAM(gp + 1);
        }
        if (IN(gp + 3)) { PH_ENTER();
            p_attn(F, layer, 0);
            __syncthreads(); SEAM(gp + 3); }
        if (IN(gp + 4)) { PH_ENTER();
#define Gt ((const bf16*)(F.ws + WS_G))
            { pg8::Gemm g{(const bf16*)(F.ws + WS_OA), (const bf16*)(F.ws + WOFF + WS_WUA), MTOK, DM, 1792, 1792}; pg8::StaticOrder S; S.init(MTOK, DM, F.G, F.bx, WGM_P4);
              pg8::EpiMergeCat E{Gt, Hb, 8, 16}; pg8::gemm_phase<pg8::EpiMergeCat, pg8::StaticOrder, true, true>(F.lds + RING_OFF, g, S, E, F.tid); }
            SEAM(gp + 4);
        }
        if (IN(gp + 5)) { PH_ENTER();
            pg8::Gemm g{Hb, (const bf16*)(F.ws + WOFF + WS_WOUT), MTOK, DM, DM, DM}; pg8::StaticOrder S; S.init(MTOK, DM, F.G, F.bx, WGM_P5);
            pg8::EpiResid<false, false, true> E{XBp, nullptr, (float*)(F.ws + WS_SSQ), (LAS float*)(F.lds + EPI_OFF)};
            pg8::gemm_phase<pg8::EpiResid<false, false, true>, pg8::StaticOrder, true, true>(F.lds + RING_OFF, g, S, E, F.tid);
            SEAM(gp + 5);
        }
        if (IN(gp + 7)) { PH_ENTER();
            pg8::Gemm g{XBp, (const bf16*)(F.ws + WOFF + WS_WFI), MTOK, DFF, DM, DM}; pg8::StaticOrder S; S.init(MTOK, DFF, F.G, F.bx, WGM_P7);
            pg8::EpiRelu2 E{(bf16*)(F.ws + WS_U), DFF};
            pg8::gemm_phase<pg8::EpiRelu2, pg8::StaticOrder, true, true>(F.lds + RING_OFF, g, S, E, F.tid);
            SEAM(gp + 7);
        }
        if (IN(gp + 8)) { PH_ENTER();
            pg8::Gemm g{(const bf16*)(F.ws + WS_U), (const bf16*)(F.ws + WOFF + WS_WFO), MTOK, DM, DFF, DFF}; pg8::StaticOrder S; S.init(MTOK, DM, F.G, F.bx, WGM_P8);
            if (layer + 1 < DEPTH) { pg8::EpiResid<false, true, false> E{XBp, nullptr, (float*)(F.ws + WS_SSQ), nullptr}; pg8::gemm_phase<pg8::EpiResid<false, true, false>, pg8::StaticOrder, true, true>(F.lds + RING_OFF, g, S, E, F.tid); }
            else { pg8::EpiResid<true, true, false> E{XBp, F.out, (float*)(F.ws + WS_SSQ), nullptr}; pg8::gemm_phase<pg8::EpiResid<true, true, false>, pg8::StaticOrder, true, true>(F.lds + RING_OFF, g, S, E, F.tid); }
            SEAM(gp + 8);
        }
    }
#undef IN
#undef SEAM
#undef Hb
#undef XBp
#undef Gt
}

extern "C" void kernel_launch(void* const* d_in, const int* in_sizes, int n_in, void* d_out, int out_size, void* d_ws, size_t ws_size, hipStream_t stream) {
    static int grid = 0;
    if (grid == 0) {
        if (n_in != 23 || in_sizes[0] != MTOK * DM || out_size != MTOK * DM || ws_size < WS_END) { fprintf(stderr, "kernel_launch: unexpected shapes (n_in %d, in0 %d, out %d, ws %zu < %zu); nothing launched\n", n_in, n_in > 0 ? in_sizes[0] : -1, out_size, ws_size, (size_t)WS_END); grid = -1; return; }
        int dev = 0, cus = 0, per_cu = 0;
        if (hipGetDevice(&dev) != hipSuccess || hipDeviceGetAttribute(&cus, hipDeviceAttributeMultiprocessorCount, dev) != hipSuccess) { grid = -1; return; }
        if (hipFuncSetAttribute((const void*)mk_fwd, hipFuncAttributeMaxDynamicSharedMemorySize, LDS_BYTES) != hipSuccess) { fprintf(stderr, "kernel_launch: hipFuncSetAttribute failed\n"); grid = -1; return; }
        if (hipOccupancyMaxActiveBlocksPerMultiprocessor(&per_cu, (const void*)mk_fwd, NWAVES * 64, LDS_BYTES) != hipSuccess || per_cu < 1)
            fprintf(stderr, "kernel_launch: note: occupancy query reports %d workgroups per CU\n", per_cu);
        (void)hipGetLastError();
        grid = (cus < 256 ? cus : 256) & ~7;
    }
    if (grid < 0) return;
    if (hipMemsetAsync((char*)d_ws + WS_CTL, 0, CTL_ZERO_BYTES, stream) != hipSuccess) { fprintf(stderr, "kernel_launch: memset failed\n"); return; }
    Args a{};
    for (int i = 0; i < 23; ++i) a.in[i] = (const float*)d_in[i];
    a.out = (float*)d_out; a.ws = (unsigned char*)d_ws;
#if MK_PER_PHASE
    for (int gp = 0; gp < DEPTH * NPH; ++gp) { if (gp % NPH == 2 || gp % NPH == 6) continue; a.gp_lo = gp; a.gp_hi = gp + 1; hipLaunchKernelGGL(mk_fwd, dim3(grid), dim3(NWAVES * 64), LDS_BYTES, stream, a); }
#else
    a.gp_lo = 0; a.gp_hi = DEPTH * NPH;
    hipLaunchKernelGGL(mk_fwd, dim3(grid), dim3(NWAVES * 64), LDS_BYTES, stream, a);
#endif
    const hipError_t le = hipPeekAtLastError();
    if (le != hipSuccess) fprintf(stderr, "kernel_launch: launch failed: %s\n", hipGetErrorName(le));
}
```
